# Optimizing an MI355X kernel written in HIP

```python
import jax, jax.numpy as jnp
from jax import lax
import numpy as np

D_MODEL = 1024
BATCH = 4
SEQ = 8192
DEPTH = 2
DEC_BATCH = 128
DEC_SEQ = 4
PAST_LEN = 16384
PAGE_SIZE = 128

N_HEADS = 16
N_KV_HEADS = 4
HEAD_DIM = 64
GROUP = N_HEADS // N_KV_HEADS
WINDOW = 128
BLOCK = WINDOW
D_RNN = D_MODEL
N_LRU_BLOCKS = 4
LRU_BLOCK = D_RNN // N_LRU_BLOCKS
CONV_WIDTH = 4
LRU_C = 8.0
D_FF = -(-8 * D_MODEL // (3 * 256)) * 256
N_ATTN_LAYERS = (DEPTH + 1) // 2
N_REC_LAYERS = DEPTH // 2
EPS = 1e-6
NEG_INF = -1e30

kernel_name = "hybrid_swa_sink_rglru_decoder_step"


def rms_norm(x, g):
    xf = x.astype(jnp.float32)
    y = xf * lax.rsqrt(jnp.mean(xf * xf, axis=-1, keepdims=True) + EPS)
    return (y * g.astype(jnp.float32)).astype(x.dtype)


def alibi_slopes():
    return 2.0 ** (-8.0 * jnp.arange(1, N_HEADS + 1, dtype=jnp.float32) / N_HEADS)


def qkv_proj(h, w_qkv):
    B, T, _ = h.shape
    qkv = h @ w_qkv
    q = qkv[..., :N_HEADS * HEAD_DIM].reshape(B, T, N_KV_HEADS, GROUP, HEAD_DIM)
    k = qkv[..., N_HEADS * HEAD_DIM:(N_HEADS + N_KV_HEADS) * HEAD_DIM].reshape(B, T, N_KV_HEADS, HEAD_DIM)
    v = qkv[..., (N_HEADS + N_KV_HEADS) * HEAD_DIM:].reshape(B, T, N_KV_HEADS, HEAD_DIM)
    return q, k, v


def sink_attend(q, k, v, dist, valid, sinks):
    s = jnp.einsum('...qkgd,...skd->...kgqs', q, k, preferred_element_type=jnp.float32) * (HEAD_DIM ** -0.5)
    slopes = alibi_slopes().reshape(N_KV_HEADS, GROUP, 1, 1)
    s = jnp.where(valid, s - slopes * dist.astype(jnp.float32), NEG_INF)
    sink = jnp.broadcast_to(sinks.astype(jnp.float32).reshape(N_KV_HEADS, GROUP, 1, 1), s.shape[:-1] + (1,))
    p = jax.nn.softmax(jnp.concatenate([s, sink], axis=-1), axis=-1)[..., :-1]
    return jnp.einsum('...kgqs,...skd->...qkgd', p.astype(v.dtype), v)


def swa_prompt(h, w_qkv, w_o, sinks):
    B, S, _ = h.shape
    nb = S // BLOCK
    q, k, v = qkv_proj(h, w_qkv)
    qb = q.reshape(B, nb, BLOCK, N_KV_HEADS, GROUP, HEAD_DIM)
    kb = k.reshape(B, nb, BLOCK, N_KV_HEADS, HEAD_DIM)
    vb = v.reshape(B, nb, BLOCK, N_KV_HEADS, HEAD_DIM)
    zk = jnp.zeros_like(kb[:, :1])
    kk = jnp.concatenate([jnp.concatenate([zk, kb[:, :-1]], axis=1), kb], axis=2)
    vv = jnp.concatenate([jnp.concatenate([zk, vb[:, :-1]], axis=1), vb], axis=2)
    qi = jnp.arange(BLOCK)[:, None]
    si = jnp.arange(2 * BLOCK)[None, :]
    dist = qi - si + BLOCK
    band = (dist >= 0) & (dist <= WINDOW)
    key_pos = jnp.arange(nb)[:, None, None] * BLOCK - BLOCK + si
    valid = (band[None] & (key_pos >= 0))[:, None, None]
    o = sink_attend(qb, kk, vv, dist, valid, sinks)
    y = o.reshape(B, S, N_HEADS * HEAD_DIM) @ w_o
    return y, k[:, S - WINDOW:], v[:, S - WINDOW:]


def swa_sample(h, cache_k, cache_v, w_qkv, w_o, sinks):
    B, T, _ = h.shape
    q, k, v = qkv_proj(h, w_qkv)
    kk = jnp.concatenate([cache_k.astype(k.dtype), k], axis=1)
    vv = jnp.concatenate([cache_v.astype(v.dtype), v], axis=1)
    qi = jnp.arange(T)[:, None]
    si = jnp.arange(WINDOW + T)[None, :]
    dist = qi - si + WINDOW
    valid = (dist >= 0) & (dist <= WINDOW)
    o = sink_attend(q, kk, vv, dist, valid, sinks)
    y = o.reshape(B, T, N_HEADS * HEAD_DIM) @ w_o
    return y, kk[:, T:], vv[:, T:]


def lru_combine(left, right):
    a1, b1 = left
    a2, b2 = right
    return a1 * a2, a2 * b1 + b2


def recurrent_block(h, conv_state, h0, w_in, conv_w, conv_b, w_rg, b_rg, w_ig, b_ig, lam, w_out):
    B, T, _ = h.shape
    gate, xb = jnp.split(h @ w_in, 2, axis=-1)
    xp = jnp.concatenate([conv_state.astype(xb.dtype), xb], axis=1)
    xc = sum((xp[:, j:j + T] * conv_w[j] for j in range(CONV_WIDTH)), conv_b)
    xr = xc.reshape(B, T, N_LRU_BLOCKS, LRU_BLOCK)
    r = jax.nn.sigmoid(jnp.einsum('btnc,ncd->btnd', xr, w_rg) + b_rg.reshape(N_LRU_BLOCKS, LRU_BLOCK)).reshape(B, T, D_RNN)
    i = jax.nn.sigmoid(jnp.einsum('btnc,ncd->btnd', xr, w_ig) + b_ig.reshape(N_LRU_BLOCKS, LRU_BLOCK)).reshape(B, T, D_RNN)
    log_a = -LRU_C * r.astype(jnp.float32) * jax.nn.softplus(-lam.astype(jnp.float32))
    a = jnp.exp(log_a)
    b = jnp.sqrt(-jnp.expm1(2.0 * log_a)) * (i * xc).astype(jnp.float32)
    b = b.at[:, 0].add(a[:, 0] * h0.astype(jnp.float32))
    _, hs = lax.associative_scan(lru_combine, (a, b), axis=1)
    y = (hs.astype(h.dtype) * jax.nn.gelu(gate)) @ w_out
    return y, xp[:, T:], hs[:, -1]


def swiglu(h, w_in, w_out):
    g, u = jnp.split(h @ w_in, 2, axis=-1)
    return (jax.nn.silu(g) * u) @ w_out


def setup_inputs(seed: int = 0) -> dict:
    key = jax.random.key(seed)
    ks = jax.random.split(key, 24)
    f32 = jnp.float32
    nrm = lambda k, shape, s: jax.random.normal(k, shape, f32) * s
    qkv_w = (N_HEADS + 2 * N_KV_HEADS) * HEAD_DIM
    u = jax.random.uniform(ks[20], (N_REC_LAYERS, D_RNN), f32, minval=0.9, maxval=0.999)
    a_base = u ** (1.0 / LRU_C)
    return {
        "x_prompt": nrm(ks[0], (BATCH, SEQ, D_MODEL), 1.0),
        "x_sample": nrm(ks[1], (DEC_BATCH, DEC_SEQ, D_MODEL), 1.0),
        "cache_k": nrm(ks[2], (N_ATTN_LAYERS, DEC_BATCH, WINDOW, N_KV_HEADS, HEAD_DIM), 1.0),
        "cache_v": nrm(ks[3], (N_ATTN_LAYERS, DEC_BATCH, WINDOW, N_KV_HEADS, HEAD_DIM), 1.0),
        "state_conv": nrm(ks[4], (N_REC_LAYERS, DEC_BATCH, CONV_WIDTH - 1, D_RNN), 1.0),
        "state_h": nrm(ks[5], (N_REC_LAYERS, DEC_BATCH, D_RNN), 0.5),
        "attn_norm": 1.0 + nrm(ks[6], (N_ATTN_LAYERS, D_MODEL), 0.02),
        "w_qkv": nrm(ks[7], (N_ATTN_LAYERS, D_MODEL, qkv_w), D_MODEL ** -0.5),
        "w_attn_out": nrm(ks[8], (N_ATTN_LAYERS, N_HEADS * HEAD_DIM, D_MODEL), (N_HEADS * HEAD_DIM) ** -0.5),
        "attn_sinks": nrm(ks[9], (N_ATTN_LAYERS, N_HEADS), 1.0),
        "rec_norm": 1.0 + nrm(ks[10], (N_REC_LAYERS, D_MODEL), 0.02),
        "w_rec_in": nrm(ks[11], (N_REC_LAYERS, D_MODEL, 2 * D_RNN), D_MODEL ** -0.5),
        "conv_w": nrm(ks[12], (N_REC_LAYERS, CONV_WIDTH, D_RNN), CONV_WIDTH ** -0.5),
        "conv_b": nrm(ks[13], (N_REC_LAYERS, D_RNN), 0.1),
        "w_rgate": nrm(ks[14], (N_REC_LAYERS, N_LRU_BLOCKS, LRU_BLOCK, LRU_BLOCK), LRU_BLOCK ** -0.5),
        "b_rgate": nrm(ks[15], (N_REC_LAYERS, D_RNN), 0.1),
        "w_igate": nrm(ks[16], (N_REC_LAYERS, N_LRU_BLOCKS, LRU_BLOCK, LRU_BLOCK), LRU_BLOCK ** -0.5),
        "b_igate": nrm(ks[17], (N_REC_LAYERS, D_RNN), 0.1),
        "lru_lambda": jnp.log(a_base) - jnp.log1p(-a_base),
        "w_rec_out": nrm(ks[18], (N_REC_LAYERS, D_RNN, D_MODEL), D_RNN ** -0.5),
        "ffn_norm": 1.0 + nrm(ks[19], (DEPTH, D_MODEL), 0.02),
        "w_ffn_in": nrm(ks[21], (DEPTH, D_MODEL, 2 * D_FF), D_MODEL ** -0.5),
        "w_ffn_out": nrm(ks[22], (DEPTH, D_FF, D_MODEL), D_FF ** -0.5),
        "final_norm": 1.0 + nrm(ks[23], (D_MODEL,), 0.02),
    }


def reference(x_prompt, x_sample, cache_k, cache_v, state_conv, state_h, attn_norm, w_qkv, w_attn_out, attn_sinks, rec_norm, w_rec_in, conv_w, conv_b, w_rgate, b_rgate, w_igate, b_igate, lru_lambda, w_rec_out, ffn_norm, w_ffn_in, w_ffn_out, final_norm):
    xp, xs = x_prompt, x_sample
    nk_p, nv_p, nk_s, nv_s = [], [], [], []
    nc_p, nh_p, nc_s, nh_s = [], [], [], []
    for layer in range(DEPTH):
        j = layer // 2
        if layer % 2 == 0:
            yp, kp, vp = swa_prompt(rms_norm(xp, attn_norm[j]), w_qkv[j], w_attn_out[j], attn_sinks[j])
            ys, ks_, vs_ = swa_sample(rms_norm(xs, attn_norm[j]), cache_k[j], cache_v[j], w_qkv[j], w_attn_out[j], attn_sinks[j])
            nk_p.append(kp); nv_p.append(vp); nk_s.append(ks_); nv_s.append(vs_)
        else:
            rec_w = (w_rec_in[j], conv_w[j], conv_b[j], w_rgate[j], b_rgate[j], w_igate[j], b_igate[j], lru_lambda[j], w_rec_out[j])
            zc = jnp.zeros((xp.shape[0], CONV_WIDTH - 1, D_RNN), xp.dtype)
            zh = jnp.zeros((xp.shape[0], D_RNN), jnp.float32)
            yp, cp, hp = recurrent_block(rms_norm(xp, rec_norm[j]), zc, zh, *rec_w)
            ys, cs, hs = recurrent_block(rms_norm(xs, rec_norm[j]), state_conv[j], state_h[j], *rec_w)
            nc_p.append(cp); nh_p.append(hp); nc_s.append(cs); nh_s.append(hs)
        xp = xp + yp
        xs = xs + ys
        xp = xp + swiglu(rms_norm(xp, ffn_norm[layer]), w_ffn_in[layer], w_ffn_out[layer])
        xs = xs + swiglu(rms_norm(xs, ffn_norm[layer]), w_ffn_in[layer], w_ffn_out[layer])
    y_prompt = rms_norm(xp, final_norm)
    y_sample = rms_norm(xs, final_norm)
    return (y_prompt, y_sample, jnp.stack(nk_p), jnp.stack(nv_p), jnp.stack(nk_s), jnp.stack(nv_s), jnp.stack(nc_p), jnp.stack(nh_p), jnp.stack(nc_s), jnp.stack(nh_s))
```

```cpp
#include <hip/hip_runtime.h>
#include <cstdio>
#include <cstdint>

constexpr int D = 1024, BATCH = 4, SEQ = 8192, DECB = 128, DECT = 4;
constexpr int NH = 16, NKV = 4, HD = 64, WIN = 128;
constexpr int DFF = 2816, QKVW = 1536;
constexpr float EPS = 1e-6f;
constexpr size_t OFF_Y_P = 0, OFF_Y_S = 33554432, OFF_NK_P = 34078720, OFF_NV_P = 34209792, OFF_NK_S = 34340864, OFF_NV_S = 38535168,
                 OFF_NC_P = 42729472, OFF_NH_P = 42741760, OFF_NC_S = 42745856, OFF_NH_S = 43139072;

__global__ void k_rmsnorm(const float* __restrict__ x, const float* __restrict__ g, float* __restrict__ y, int rows) {
    int row = blockIdx.x * (blockDim.x / 64) + threadIdx.x / 64, lane = threadIdx.x & 63;
    if (row >= rows) return;
    const float* xr = x + (size_t)row * D; float s = 0.f;
    for (int i = lane; i < D; i += 64) { float v = xr[i]; s += v * v; }
    for (int o = 32; o; o >>= 1) s += __shfl_xor(s, o);
    float r = rsqrtf(s / D + EPS);
    for (int i = lane; i < D; i += 64) y[(size_t)row * D + i] = xr[i] * r * g[i];
}
__global__ void k_gemm(const float* __restrict__ A, int lda, const float* __restrict__ B, int ldb, float* C, int ldc, const float* R, int ldr, int K) {
    __shared__ float As[16][65], Bs[16][65];
    int tx = threadIdx.x & 15, ty = threadIdx.x >> 4, m0 = blockIdx.y * 64, n0 = blockIdx.x * 64;
    float acc[4][4] = {};
    for (int k0 = 0; k0 < K; k0 += 16) {
        for (int i = threadIdx.x; i < 64 * 16; i += 256) { int r = i >> 4, c = i & 15; As[c][r] = A[(size_t)(m0 + r) * lda + k0 + c]; }
        for (int i = threadIdx.x; i < 16 * 64; i += 256) { int r = i >> 6, c = i & 63; Bs[r][c] = B[(size_t)(k0 + r) * ldb + n0 + c]; }
        __syncthreads();
#pragma unroll
        for (int k = 0; k < 16; ++k) {
            float a[4], b[4];
#pragma unroll
            for (int i = 0; i < 4; ++i) { a[i] = As[k][ty * 4 + i]; b[i] = Bs[k][tx * 4 + i]; }
#pragma unroll
            for (int i = 0; i < 4; ++i)
#pragma unroll
                for (int j = 0; j < 4; ++j) acc[i][j] += a[i] * b[j];
        }
        __syncthreads();
    }
    for (int i = 0; i < 4; ++i)
        for (int j = 0; j < 4; ++j) {
            size_t r = m0 + ty * 4 + i, c = n0 + tx * 4 + j; float v = acc[i][j];
            if (R) v += R[r * ldr + c];
            C[r * ldc + c] = v;
        }
}
__global__ void k_attn_prompt(const float* __restrict__ qkv, const float* __restrict__ sinks, float* __restrict__ o) {
    int w = blockIdx.x * (blockDim.x / 64) + threadIdx.x / 64, lane = threadIdx.x & 63;
    int t = w / NH, h = w % NH, kv = h / 4;
    if (t >= SEQ) return;
    const float* q = qkv + (size_t)t * QKVW + h * HD;
    float slope = exp2f(-0.5f * (h + 1));
    float sc[3]; float mx = sinks[h];
    for (int i = 0; i < 3; ++i) {
        int j = lane + 64 * i; int s = t - 128 + j; float v = -1e30f;
        if (j <= 128 && s >= 0) { const float* k = qkv + (size_t)s * QKVW + 1024 + kv * HD; float d = 0.f; for (int e = 0; e < HD; ++e) d += q[e] * k[e]; v = d * 0.125f - slope * (float)(128 - j); }
        sc[i] = v; mx = fmaxf(mx, v);
    }
    for (int off = 32; off; off >>= 1) mx = fmaxf(mx, __shfl_xor(mx, off));
    float l = 0.f;
    for (int i = 0; i < 3; ++i) { int j = lane + 64 * i; int s = t - 128 + j; float p = (j <= 128 && s >= 0) ? expf(sc[i] - mx) : 0.f; sc[i] = p; l += p; }
    for (int off = 32; off; off >>= 1) l += __shfl_xor(l, off);
    l += expf(sinks[h] - mx);
    float acc = 0.f;
    for (int j = 0; j <= 128; ++j) { int s = t - 128 + j; if (s < 0) continue; float p = __shfl(sc[j >> 6], j & 63); acc += p * qkv[(size_t)s * QKVW + 1280 + kv * HD + lane]; }
    o[(size_t)t * D + h * HD + lane] = acc / l;
}
__global__ void k_attn_sample(const float* __restrict__ qkv, const float* __restrict__ ck, const float* __restrict__ cv, const float* __restrict__ sinks, float* __restrict__ o) {
    int w = blockIdx.x * (blockDim.x / 64) + threadIdx.x / 64, lane = threadIdx.x & 63;
    int h = w % NH, t = (w / NH) % DECT, b = w / (NH * DECT), kv = h / 4;
    if (b >= DECB) return;
    const float* q = qkv + (size_t)(b * DECT + t) * QKVW + h * HD;
    float slope = exp2f(-0.5f * (h + 1));
    float sc[3]; float mx = sinks[h];
    for (int i = 0; i < 3; ++i) {
        int si = lane + 64 * i; float v = -1e30f; int dist = t - si + 128;
        if (si < 132 && dist >= 0 && dist <= 128) {
            const float* k = si < 128 ? ck + ((size_t)(b * 128 + si) * NKV + kv) * HD : qkv + (size_t)(b * DECT + si - 128) * QKVW + 1024 + kv * HD;
            float d = 0.f; for (int e = 0; e < HD; ++e) d += q[e] * k[e]; v = d * 0.125f - slope * (float)dist; }
        sc[i] = v; mx = fmaxf(mx, v);
    }
    for (int off = 32; off; off >>= 1) mx = fmaxf(mx, __shfl_xor(mx, off));
    float l = 0.f;
    for (int i = 0; i < 3; ++i) { float p = sc[i] > -1e29f ? expf(sc[i] - mx) : 0.f; sc[i] = p; l += p; }
    for (int off = 32; off; off >>= 1) l += __shfl_xor(l, off);
    l += expf(sinks[h] - mx);
    float acc = 0.f;
    for (int si = 0; si < 132; ++si) { float p = __shfl(sc[si >> 6], si & 63);
        const float* v = si < 128 ? cv + ((size_t)(b * 128 + si) * NKV + kv) * HD : qkv + (size_t)(b * DECT + si - 128) * QKVW + 1280 + kv * HD;
        acc += p * v[lane]; }
    o[(size_t)(b * DECT + t) * D + h * HD + lane] = acc / l;
}
__global__ void k_newkv_prompt(const float* __restrict__ qkv, float* __restrict__ nk, float* __restrict__ nv) {
    int i = blockIdx.x * blockDim.x + threadIdx.x; if (i >= 128 * 256) return;
    int w = i / 256, c = i % 256; const float* r = qkv + (size_t)(SEQ - 128 + w) * QKVW;
    nk[i] = r[1024 + c]; nv[i] = r[1280 + c];
}
__global__ void k_newkv_sample(const float* __restrict__ qkv, const float* __restrict__ ck, const float* __restrict__ cv, float* __restrict__ nk, float* __restrict__ nv) {
    int i = blockIdx.x * blockDim.x + threadIdx.x; if (i >= DECB * 128 * 256) return;
    int c = i % 256, w = (i / 256) % 128, b = i / (256 * 128); int si = w + 4;
    if (si < 128) { nk[i] = ck[((size_t)b * 128 + si) * 256 + c]; nv[i] = cv[((size_t)b * 128 + si) * 256 + c]; }
    else { const float* r = qkv + (size_t)(b * DECT + si - 128) * QKVW; nk[i] = r[1024 + c]; nv[i] = r[1280 + c]; }
}
__global__ void k_swiglu(const float* __restrict__ h, float* __restrict__ a, int rows) {
    size_t i = (size_t)blockIdx.x * blockDim.x + threadIdx.x; if (i >= (size_t)rows * DFF) return;
    size_t r = i / DFF, c = i % DFF; float g = h[r * 2 * DFF + c], u = h[r * 2 * DFF + DFF + c];
    a[i] = g / (1.f + expf(-g)) * u;
}
__global__ void k_conv(const float* __restrict__ gx, const float* __restrict__ cs, const float* __restrict__ cw, const float* __restrict__ cb, float* __restrict__ xc, float* __restrict__ nc, int B, int T) {
    size_t i = (size_t)blockIdx.x * blockDim.x + threadIdx.x; if (i >= (size_t)B * T * D) return;
    int d = i % D, t = (i / D) % T, b = i / ((size_t)D * T);
    float acc = cb[d];
    for (int j = 0; j < 4; ++j) { int tt = t + j - 3; float v;
        if (tt >= 0) v = gx[((size_t)b * T + tt) * 2048 + 1024 + d]; else v = cs ? cs[((size_t)b * 3 + (tt + 3)) * D + d] : 0.f;
        acc += v * cw[j * D + d]; }
    xc[i] = acc;
    if (t >= T - 3) nc[((size_t)b * 3 + (t - (T - 3))) * D + d] = gx[((size_t)b * T + t) * 2048 + 1024 + d];
}
__global__ void k_ab(float* __restrict__ rp, float* __restrict__ ip, const float* __restrict__ xc, const float* __restrict__ brg, const float* __restrict__ big, const float* __restrict__ lam, int rows) {
    size_t i = (size_t)blockIdx.x * blockDim.x + threadIdx.x; if (i >= (size_t)rows * D) return;
    int d = i % D;
    float r = 1.f / (1.f + expf(-(rp[i] + brg[d]))), g = 1.f / (1.f + expf(-(ip[i] + big[d])));
    float nl = -lam[d]; float sp = nl > 20.f ? nl : log1pf(expf(nl));
    float la = -8.f * r * sp; float a = expf(la); float b = sqrtf(-expm1f(2.f * la)) * (g * xc[i]);
    rp[i] = a; ip[i] = b;
}
__global__ void k_scan(const float* __restrict__ aa, float* __restrict__ bb, const float* __restrict__ h0, float* __restrict__ nh, int B, int T) {
    int i = blockIdx.x * blockDim.x + threadIdx.x; if (i >= B * D) return;
    int d = i % D, b = i / D; float h = h0 ? h0[(size_t)b * D + d] : 0.f;
    for (int t = 0; t < T; ++t) { size_t idx = ((size_t)b * T + t) * D + d; h = aa[idx] * h + bb[idx]; bb[idx] = h; }
    nh[(size_t)b * D + d] = h;
}
__global__ void k_mulgelu(float* __restrict__ hs, const float* __restrict__ gx, int rows) {
    size_t i = (size_t)blockIdx.x * blockDim.x + threadIdx.x; if (i >= (size_t)rows * D) return;
    size_t r = i / D, c = i % D; float g = gx[r * 2048 + c];
    float ge = 0.5f * g * (1.f + tanhf(0.7978845608028654f * (g + 0.044715f * g * g * g)));
    hs[i] = hs[i] * ge;
}

static void gemm(hipStream_t s, const float* A, int lda, const float* B, int ldb, float* C, int ldc, const float* R, int ldr, int M, int N, int K) {
    hipLaunchKernelGGL(k_gemm, dim3(N / 64, M / 64), dim3(256), 0, s, A, lda, B, ldb, C, ldc, R, ldr, K);
}

extern "C" void kernel_launch(void* const* d_in, const int* in_sizes, int n_in, void* d_out, int out_size, void* d_ws, size_t ws_size, hipStream_t stream) {
    const float* x_prompt = (const float*)d_in[0]; const float* x_sample = (const float*)d_in[1];
    const float* cache_k = (const float*)d_in[2]; const float* cache_v = (const float*)d_in[3];
    const float* state_conv = (const float*)d_in[4]; const float* state_h = (const float*)d_in[5];
    const float* attn_norm = (const float*)d_in[6]; const float* w_qkv = (const float*)d_in[7]; const float* w_o = (const float*)d_in[8];
    const float* sinks = (const float*)d_in[9]; const float* rec_norm = (const float*)d_in[10]; const float* w_rec_in = (const float*)d_in[11];
    const float* conv_w = (const float*)d_in[12]; const float* conv_b = (const float*)d_in[13]; const float* w_rg = (const float*)d_in[14];
    const float* b_rg = (const float*)d_in[15]; const float* w_ig = (const float*)d_in[16]; const float* b_ig = (const float*)d_in[17];
    const float* lam = (const float*)d_in[18]; const float* w_rec_out = (const float*)d_in[19]; const float* ffn_norm = (const float*)d_in[20];
    const float* w_ffn_in = (const float*)d_in[21]; const float* w_ffn_out = (const float*)d_in[22]; const float* final_norm = (const float*)d_in[23];
    float* out = (float*)d_out; float* ws = (float*)d_ws;
    const size_t R8 = 8192;
    float* XN = ws;
    float* BIG = XN + R8 * 1024;
    float* B2 = BIG + R8 * 5632;
    float* B3 = B2 + R8 * 2816;
    float* B4 = B3 + R8 * 1024;
    float* XR = B4 + R8 * 1024;
    for (int c = 0; c < 5; ++c) {
        const bool smp = (c == 4); const int rows = smp ? DECB * DECT : SEQ; const int B = smp ? DECB : 1, T = smp ? DECT : SEQ;
        const float* xin = smp ? x_sample : x_prompt + (size_t)c * SEQ * D;
        float* yout = smp ? out + OFF_Y_S : out + OFF_Y_P + (size_t)c * SEQ * D;
        const int nb = (rows * 64 + 255) / 256;
        hipLaunchKernelGGL(k_rmsnorm, dim3(nb), dim3(256), 0, stream, xin, attn_norm, XN, rows);
        gemm(stream, XN, D, w_qkv, QKVW, BIG, QKVW, nullptr, 0, rows, QKVW, D);
        if (!smp) {
            hipLaunchKernelGGL(k_attn_prompt, dim3(SEQ * NH / 4), dim3(256), 0, stream, BIG, sinks, B3);
            hipLaunchKernelGGL(k_newkv_prompt, dim3(128), dim3(256), 0, stream, BIG, out + OFF_NK_P + (size_t)c * 128 * 256, out + OFF_NV_P + (size_t)c * 128 * 256);
        } else {
            hipLaunchKernelGGL(k_attn_sample, dim3(DECB * DECT * NH / 4), dim3(256), 0, stream, BIG, cache_k, cache_v, sinks, B3);
            hipLaunchKernelGGL(k_newkv_sample, dim3(DECB * 128), dim3(256), 0, stream, BIG, cache_k, cache_v, out + OFF_NK_S, out + OFF_NV_S);
        }
        gemm(stream, B3, D, w_o, D, XR, D, xin, D, rows, D, D);
        hipLaunchKernelGGL(k_rmsnorm, dim3(nb), dim3(256), 0, stream, XR, ffn_norm, XN, rows);
        gemm(stream, XN, D, w_ffn_in, 2 * DFF, BIG, 2 * DFF, nullptr, 0, rows, 2 * DFF, D);
        hipLaunchKernelGGL(k_swiglu, dim3((unsigned)(((size_t)rows * DFF + 255) / 256)), dim3(256), 0, stream, BIG, B2, rows);
        gemm(stream, B2, DFF, w_ffn_out, D, XR, D, XR, D, rows, D, DFF);
        hipLaunchKernelGGL(k_rmsnorm, dim3(nb), dim3(256), 0, stream, XR, rec_norm, XN, rows);
        gemm(stream, XN, D, w_rec_in, 2048, BIG, 2048, nullptr, 0, rows, 2048, D);
        const unsigned ne = (unsigned)(((size_t)rows * D + 255) / 256);
        hipLaunchKernelGGL(k_conv, dim3(ne), dim3(256), 0, stream, BIG, smp ? state_conv : nullptr, conv_w, conv_b, B2, smp ? out + OFF_NC_S : out + OFF_NC_P + (size_t)c * 3 * D, B, T);
        for (int n = 0; n < 4; ++n) {
            gemm(stream, B2 + n * 256, D, w_rg + (size_t)n * 65536, 256, B3 + n * 256, D, nullptr, 0, rows, 256, 256);
            gemm(stream, B2 + n * 256, D, w_ig + (size_t)n * 65536, 256, B4 + n * 256, D, nullptr, 0, rows, 256, 256);
        }
        hipLaunchKernelGGL(k_ab, dim3(ne), dim3(256), 0, stream, B3, B4, B2, b_rg, b_ig, lam, rows);
        hipLaunchKernelGGL(k_scan, dim3((B * D + 255) / 256), dim3(256), 0, stream, B3, B4, smp ? state_h : nullptr, smp ? out + OFF_NH_S : out + OFF_NH_P + (size_t)c * D, B, T);
        hipLaunchKernelGGL(k_mulgelu, dim3(ne), dim3(256), 0, stream, B4, BIG, rows);
        gemm(stream, B4, D, w_rec_out, D, XR, D, XR, D, rows, D, D);
        hipLaunchKernelGGL(k_rmsnorm, dim3(nb), dim3(256), 0, stream, XR, ffn_norm + D, XN, rows);
        gemm(stream, XN, D, w_ffn_in + (size_t)D * 2 * DFF, 2 * DFF, BIG, 2 * DFF, nullptr, 0, rows, 2 * DFF, D);
        hipLaunchKernelGGL(k_swiglu, dim3((unsigned)(((size_t)rows * DFF + 255) / 256)), dim3(256), 0, stream, BIG, B2, rows);
        gemm(stream, B2, DFF, w_ffn_out + (size_t)DFF * D, D, XR, D, XR, D, rows, D, DFF);
        hipLaunchKernelGGL(k_rmsnorm, dim3(nb), dim3(256), 0, stream, XR, final_norm, yout, rows);
    }
}
```

```cpp
#include <hip/hip_runtime.h>
#include <cstdio>
#include <cstdint>
#ifndef MK_ONE_LAUNCH
#define MK_ONE_LAUNCH 0
#endif
namespace pg8 {
#define PG8_LAS __attribute__((address_space(3)))
typedef unsigned short bf16_t;
typedef short bf16x8 __attribute__((ext_vector_type(8)));
typedef float f32x4 __attribute__((ext_vector_type(4)));
typedef unsigned u32x4 __attribute__((ext_vector_type(4)));
constexpr int BM = 256, BK = 64, HALF = 128, HTB = HALF * BK * 2  , STAGE_BYTES = 8 * HTB, NXCD = 8, WGM = 8;

__host__ __device__ __forceinline__ int lds_byte(int r, int c) { const int st = (r >> 4) * 2 + (c >> 5), rr = r & 15, cc = c & 31, ob = rr * 64 + cc * 2; return st * 1024 + (ob ^ (((ob >> 9) & 1) << 5)); }
__host__ __device__ __forceinline__ void stage_rc(int b, int& R, int& C) { const int st = b / 1024, sb = b % 1024, swz = sb ^ (((sb >> 9) & 1) << 5); R = (st >> 1) * 16 + swz / 64; C = (st & 1) * 32 + (swz % 64) / 2; }
__host__ __device__ __forceinline__ int perm32(int rho) { const int n = rho >> 4, i = rho & 15; return 8 * (i >> 2) + 4 * n + (i & 3); }

struct Unit { int pm, pn; };
struct Gemm { const bf16_t* A; const bf16_t* Bt; int K, lda, ldb, acol_shift, acol_bytes;
    __device__ __forceinline__ const char* abase(const Unit& u) const { return (const char*)A + (size_t)u.pm * 512 * lda + (size_t)((u.pn >> acol_shift) * acol_bytes); }
    __device__ __forceinline__ const char* bbase(const Unit& u) const { return (const char*)Bt + (size_t)u.pn * 512 * ldb; } };

struct StaticOrder {
    int nM, nN, nwg, G, c;
    __host__ __device__ void init(int M, int N, int G_, int c_) { nM = M / BM; nN = N / BM; nwg = nM * nN; G = G_; c = c_; }
    __host__ __device__ bool next(int i, Unit& u) const {
        const long L = (long)i * G + c; if (L >= nwg) return false;
        int wgid = (int)L; { const int q = nwg / NXCD, r = nwg % NXCD, xcd = wgid % NXCD, off = wgid / NXCD; wgid = (xcd < r ? xcd * (q + 1) : r * (q + 1) + (xcd - r) * q) + off; }
        const int nig = WGM * nN, gid = wgid / nig, fm = gid * WGM, gsz = (nM - fm) < WGM ? (nM - fm) : WGM;
        u.pm = fm + ((wgid % nig) % gsz); u.pn = (wgid % nig) / gsz; return true;
    }
    __device__ __forceinline__ void a_ready(const Unit&) const {}
    __device__ __forceinline__ void done(const Unit&) const {}
};

template <class Epi, class Sched, bool ALIGN_EPI = false, bool SP2 = false>
__device__ __forceinline__ void gemm_phase(PG8_LAS unsigned char* lds, const int wid, const Gemm g, const Sched& S, const Epi& E) {
    unsigned z_ = 0u; asm volatile("" : "+v"(z_));
    const int lane = (int)__builtin_amdgcn_mbcnt_hi(~0u, __builtin_amdgcn_mbcnt_lo(~0u, z_)), tid = wid * 64 + lane, wr = wid >> 2, wc = wid & 3, fr = lane & 15, fq = lane >> 4;
    const int K = g.K, nt = K / BK;
    unsigned voffA[2], voffB[2];
#pragma unroll
    for (int i = 0; i < 2; ++i) { int R, C; stage_rc(tid * 16 + i * 8192, R, C); const int Rb = Epi::PERM ? ((R & ~31) + perm32(R & 31)) : R;
        voffA[i] = (unsigned)(R * g.lda + C) * 2u; voffB[i] = (unsigned)(Rb * g.ldb + C) * 2u; }
    const size_t kstep = (size_t)(BK * 2);
    const size_t hstepA = (size_t)HALF * g.lda * 2, hstepB = (size_t)HALF * g.ldb * 2;

    const unsigned ldsw = (unsigned)wid * 1024u;
    const int aoff = lds_byte(wr * 64 + fr, fq * 8), boff = lds_byte(wc * 32 + fr, fq * 8);
#define PG8_SA(b, h) (((b) * 2 + (h)) * HTB)
#define PG8_SB(b, h) ((4 + (b) * 2 + (h)) * HTB)
#define PG8_STAGE(bufoff, gbase, voff) do { _Pragma("unroll") for (int _i = 0; _i < 2; ++_i) \
        __builtin_amdgcn_global_load_lds((const unsigned*)((const char*)(gbase) + (voff)[_i]), (PG8_LAS unsigned*)(lds + (bufoff) + ldsw + _i * 8192), 16, 0, 0); } while (0)
#define PG8_LDA(dst, b, h) do { _Pragma("unroll") for (int m = 0; m < 4; ++m) _Pragma("unroll") for (int k = 0; k < 2; ++k) dst[m][k] = *(const PG8_LAS bf16x8*)(lds + PG8_SA(b, h) + aoff + m * 2048 + k * 1024); } while (0)
#define PG8_LDB(dst, b, h) do { _Pragma("unroll") for (int n = 0; n < 2; ++n) _Pragma("unroll") for (int k = 0; k < 2; ++k) dst[n][k] = *(const PG8_LAS bf16x8*)(lds + PG8_SB(b, h) + boff + n * 2048 + k * 1024); } while (0)
#define PG8_MMA(ai, bj, At, Bt) do { __builtin_amdgcn_s_setprio(1); _Pragma("unroll") for (int m = 0; m < 4; ++m) _Pragma("unroll") for (int n = 0; n < 2; ++n) _Pragma("unroll") for (int k = 0; k < 2; ++k) \
        acc[ai][bj][m][n] = __builtin_amdgcn_mfma_f32_16x16x32_bf16(Bt[n][k], At[m][k], acc[ai][bj][m][n], 0, 0, 0); __builtin_amdgcn_s_setprio(0); } while (0)
#define PG8_WAIT_V(n) asm volatile("s_waitcnt vmcnt(" #n ")" ::: "memory")
#define PG8_WAIT_L(n) asm volatile("s_waitcnt lgkmcnt(" #n ")" ::: "memory")
#define PG8_BAR __builtin_amdgcn_s_barrier()
#define PG8_SCHED __builtin_amdgcn_sched_barrier(0)
    Unit cur, nxt; int ui = 0;
    if (!S.next(0, cur)) return;
    f32x4 acc[2][2][4][2];
#pragma unroll
    for (int a = 0; a < 2; ++a)
#pragma unroll
        for (int b = 0; b < 2; ++b)
#pragma unroll
            for (int m = 0; m < 4; ++m)
#pragma unroll
                for (int n = 0; n < 2; ++n) acc[a][b][m][n] = (f32x4){0.f, 0.f, 0.f, 0.f};
    bf16x8 At[4][2], B0[2][2], B1[2][2];
    const char* cA = g.abase(cur); const char* cB = g.bbase(cur);
    S.a_ready(cur);
    if constexpr (SP2) {
        PG8_STAGE(PG8_SB(0, 0), cB, voffB); PG8_STAGE(PG8_SB(0, 1), cB + hstepB, voffB); PG8_STAGE(PG8_SA(0, 0), cA, voffA); PG8_STAGE(PG8_SA(0, 1), cA + hstepA, voffA);
        if (wr == 1) PG8_BAR;
        PG8_WAIT_V(2); PG8_BAR;
        PG8_STAGE(PG8_SB(1, 0), cB + kstep, voffB); PG8_STAGE(PG8_SA(1, 0), cA + kstep, voffA); PG8_STAGE(PG8_SB(1, 1), cB + hstepB + kstep, voffB);
        PG8_WAIT_V(6); PG8_BAR;
    } else {
        PG8_STAGE(PG8_SB(0, 0), cB, voffB); PG8_STAGE(PG8_SA(0, 0), cA, voffA); PG8_STAGE(PG8_SB(0, 1), cB + hstepB, voffB); PG8_STAGE(PG8_SA(0, 1), cA + hstepA, voffA);
        if (wr == 1) PG8_BAR;
        PG8_WAIT_V(4); PG8_BAR;
        PG8_STAGE(PG8_SB(1, 0), cB + kstep, voffB); PG8_STAGE(PG8_SA(1, 0), cA + kstep, voffA); PG8_STAGE(PG8_SB(1, 1), cB + hstepB + kstep, voffB);
        PG8_WAIT_V(6); PG8_BAR;
    }
    for (;;) {
        const bool has_next = S.next(ui + 1, nxt);
        const char* nA = has_next ? g.abase(nxt) : cA; const char* nB = has_next ? g.bbase(nxt) : cB;
        for (int t = 0; t < nt; t += 2) {
            const bool last = (t == nt - 2);
            const char* a1 = cA + (size_t)(t + 1) * kstep;
            const char* a2 = last ? nA : cA + (size_t)(t + 2) * kstep; const char* b2 = last ? nB : cB + (size_t)(t + 2) * kstep;
            const char* a3 = a2 + kstep; const char* b3 = b2 + kstep;
            if (last && has_next) S.a_ready(nxt);
            if constexpr (SP2) {
            PG8_LDB(B0, 0, 0); PG8_LDB(B1, 0, 1); PG8_SCHED; PG8_LDA(At, 0, 0); PG8_STAGE(PG8_SA(1, 1), a1 + hstepA, voffA);
            PG8_WAIT_V(8); PG8_WAIT_L(0); PG8_BAR; PG8_MMA(0, 0, At, B0); PG8_MMA(0, 1, At, B1); PG8_BAR; PG8_SCHED;
            PG8_LDA(At, 0, 1); PG8_STAGE(PG8_SB(0, 0), b2, voffB); PG8_STAGE(PG8_SB(0, 1), b2 + hstepB, voffB); PG8_STAGE(PG8_SA(0, 0), a2, voffA);
            PG8_WAIT_V(8); PG8_WAIT_L(0); PG8_BAR; PG8_MMA(1, 0, At, B0); PG8_MMA(1, 1, At, B1); PG8_BAR; PG8_SCHED;
            PG8_LDB(B0, 1, 0); PG8_LDB(B1, 1, 1); PG8_SCHED; PG8_LDA(At, 1, 0); PG8_STAGE(PG8_SA(0, 1), a2 + hstepA, voffA);
            PG8_WAIT_V(8); PG8_WAIT_L(0); PG8_BAR; PG8_MMA(0, 0, At, B0); PG8_MMA(0, 1, At, B1); PG8_BAR; PG8_SCHED;
            PG8_LDA(At, 1, 1); PG8_STAGE(PG8_SB(1, 0), b3, voffB); PG8_STAGE(PG8_SB(1, 1), b3 + hstepB, voffB); PG8_STAGE(PG8_SA(1, 0), a3, voffA);
            PG8_WAIT_V(8); PG8_WAIT_L(0); PG8_BAR; PG8_MMA(1, 0, At, B0); PG8_MMA(1, 1, At, B1); PG8_BAR; PG8_SCHED;
            } else {
            PG8_LDB(B0, 0, 0); PG8_SCHED; PG8_LDA(At, 0, 0); PG8_STAGE(PG8_SA(1, 1), a1 + hstepA, voffA);
            PG8_WAIT_L(8); PG8_BAR; PG8_WAIT_L(0); PG8_MMA(0, 0, At, B0); PG8_BAR; PG8_SCHED;
            PG8_LDB(B1, 0, 1); PG8_STAGE(PG8_SB(0, 0), b2, voffB);
            PG8_BAR; PG8_WAIT_L(0); PG8_MMA(0, 1, At, B1); PG8_BAR;
            PG8_LDA(At, 0, 1); PG8_STAGE(PG8_SA(0, 0), a2, voffA);
            PG8_BAR; PG8_WAIT_L(0); PG8_MMA(1, 0, At, B0); PG8_BAR; PG8_SCHED;
            PG8_STAGE(PG8_SB(0, 1), b2 + hstepB, voffB);
            PG8_WAIT_V(6); PG8_BAR; PG8_MMA(1, 1, At, B1); PG8_BAR;
            PG8_LDB(B0, 1, 0); PG8_SCHED; PG8_LDA(At, 1, 0); PG8_STAGE(PG8_SA(0, 1), a2 + hstepA, voffA);
            PG8_WAIT_L(8); PG8_BAR; PG8_WAIT_L(0); PG8_MMA(0, 0, At, B0); PG8_BAR; PG8_SCHED;
            PG8_LDB(B1, 1, 1); PG8_STAGE(PG8_SB(1, 0), b3, voffB);
            PG8_BAR; PG8_WAIT_L(0); PG8_MMA(0, 1, At, B1); PG8_BAR;
            PG8_LDA(At, 1, 1); PG8_STAGE(PG8_SA(1, 0), a3, voffA);
            PG8_BAR; PG8_WAIT_L(0); PG8_MMA(1, 0, At, B0); PG8_BAR; PG8_SCHED;
            PG8_STAGE(PG8_SB(1, 1), b3 + hstepB, voffB);
            PG8_WAIT_V(6); PG8_BAR; PG8_MMA(1, 1, At, B1); PG8_BAR;
            }
        }
        if constexpr (ALIGN_EPI) { if (wr == 0) PG8_BAR; }
        if constexpr (!Epi::AFTER_DRAIN) { E(acc, cur, wr, wc, fr, fq); S.done(cur); }
        if (!has_next) break;
#pragma unroll
        for (int a = 0; a < 2; ++a)
#pragma unroll
            for (int b = 0; b < 2; ++b)
#pragma unroll
                for (int m = 0; m < 4; ++m)
#pragma unroll
                    for (int n = 0; n < 2; ++n) acc[a][b][m][n] = (f32x4){0.f, 0.f, 0.f, 0.f};
        cur = nxt; cA = nA; cB = nB; ++ui;
        if constexpr (ALIGN_EPI) { if (wr == 1) PG8_BAR; }
    }
    PG8_WAIT_V(0);
    if constexpr (!ALIGN_EPI) { if (wr == 0) PG8_BAR; }
    PG8_BAR;
    if constexpr (Epi::AFTER_DRAIN) { E.fused(acc, cur, wr, wc, fr, fq, lds, wid, lane); S.done(cur); }
#undef PG8_SA
#undef PG8_SB
#undef PG8_STAGE
#undef PG8_LDA
#undef PG8_LDB
#undef PG8_MMA
#undef PG8_WAIT_V
#undef PG8_WAIT_L
#undef PG8_BAR
#undef PG8_SCHED
}
}

constexpr int D = 1024, BATCH = 4, SEQ = 8192, DECB = 128, DECT = 4;
constexpr int MP = BATCH * SEQ, MS = DECB * DECT, M = MP + MS;
constexpr int NH = 16, NKV = 4, HD = 64, DFF = 2816, NQKV = 1536;
constexpr float EPS = 1e-6f, LOG2E = 1.4426950408889634f, C2 = 0.125f * LOG2E;
constexpr size_t OFF_Y = 0, OFF_NK_P = 34078720, OFF_NV_P = 34209792, OFF_NK_S = 34340864, OFF_NV_S = 38535168,
                 OFF_NC_P = 42729472, OFF_NH_P = 42741760, OFF_NC_S = 42745856, OFF_NH_S = 43139072;
constexpr size_t MiB = 1u << 20;
constexpr size_t WS_CTL = 0, CTL_ZERO_BYTES = 1 * MiB;
constexpr size_t WS_WQKV = 2 * MiB, WS_WO = 5 * MiB, WS_WFI0 = 7 * MiB, WS_WFO0 = 18 * MiB, WS_WRI = 24 * MiB, WS_WG = 28 * MiB, WS_WRO = 29 * MiB, WS_WFI1 = 31 * MiB, WS_WFO1 = 42 * MiB;
constexpr size_t WS_SS = 48 * MiB;
constexpr size_t WS_SLA = 51 * MiB, WS_HT = 52 * MiB;
constexpr size_t WS_XB = 56 * MiB;
constexpr size_t WS_R = 128 * MiB;
constexpr size_t WS_Q = WS_R, WS_K = WS_R + 65 * MiB, WS_V = WS_R + 82 * MiB, WS_O = WS_R + 99 * MiB;
constexpr size_t WS_H = WS_R;
constexpr size_t WS_GG = WS_R, WS_XBC = WS_R + 65 * MiB, WS_XC = WS_R + 130 * MiB, WS_LA = WS_R + 195 * MiB, WS_BB = WS_R + 260 * MiB;
constexpr size_t WS_END = WS_R + 325 * MiB;
static_assert(WS_END <= 512 * MiB, "ws map");
constexpr int CW_TMO = 0, CW_BAR = 4096;
constexpr int RING_BYTES = 131072, LDSCTL_OFF = RING_BYTES, MISC_OFF = LDSCTL_OFF + 320, LDS_BYTES = 147456;
constexpr int NWAVES = 8;

#define GAS __attribute__((address_space(1)))
#define LAS __attribute__((address_space(3)))
typedef unsigned short bf16;
typedef unsigned v4u __attribute__((ext_vector_type(4)));
typedef unsigned v2u __attribute__((ext_vector_type(2)));
typedef float f32x4 __attribute__((ext_vector_type(4)));
typedef float f32x2 __attribute__((ext_vector_type(2)));
typedef float f32x16 __attribute__((ext_vector_type(16)));
typedef short bf16x8 __attribute__((ext_vector_type(8)));
typedef short s16x4 __attribute__((ext_vector_type(4)));
typedef _Float16 h16x2 __attribute__((ext_vector_type(2)));
typedef _Float16 h16x8 __attribute__((ext_vector_type(8)));
typedef GAS unsigned gu32;
#define RLX_AGENT __ATOMIC_RELAXED, __HIP_MEMORY_SCOPE_AGENT
#define LDS_WAIT() asm volatile("s_waitcnt lgkmcnt(0)" ::: "memory")
#define VM_WAIT() asm volatile("s_waitcnt vmcnt(0)" ::: "memory")
__device__ __forceinline__ unsigned f2bf(float f) { unsigned u = __builtin_bit_cast(unsigned, f); return (u + 0x7fffu + ((u >> 16) & 1u)) >> 16; }
__device__ __forceinline__ unsigned pk2(float lo, float hi) { return f2bf(lo) | (f2bf(hi) << 16); }
__device__ __forceinline__ float bf2f(unsigned short b) { return __builtin_bit_cast(float, (unsigned)b << 16); }
__device__ __forceinline__ float bflo(unsigned w) { return __builtin_bit_cast(float, w << 16); }
__device__ __forceinline__ float bfhi(unsigned w) { return __builtin_bit_cast(float, w & 0xffff0000u); }
__device__ __forceinline__ float ex2(float x) { return __builtin_amdgcn_exp2f(x); }
__device__ __forceinline__ float rcpf_(float x) { return __builtin_amdgcn_rcpf(x); }
__device__ __forceinline__ float wave_sum(float v) {
#pragma unroll
    for (int o = 1; o < 64; o <<= 1) v += __shfl_xor(v, o);
    return v;
}
__device__ __forceinline__ float wave_max(float v) {
#pragma unroll
    for (int o = 1; o < 64; o <<= 1) v = fmaxf(v, __shfl_xor(v, o));
    return v;
}

__device__ __forceinline__ int xb_lane_id() { unsigned z = 0u; asm volatile("" : "+v"(z)); return (int)__builtin_amdgcn_mbcnt_hi(~0u, __builtin_amdgcn_mbcnt_lo(~0u, z)); }
#define XB_T0(b) ((b).wave == 0 && xb_lane_id() == 0)
#define XB_TMO      128
#define XB_XCNT(j)  (256  + 64 * (j))
#define XB_XSUB(j)  (1280 + 64 * (j))
#define XB_XGEN(j)  (2304 + 64 * (j))
#define XB_TOP      3328
#define XB_TOPGEN   3392
#define XCD_BAR_WORDS 3456
#define XB_SPIN_CAP (1u << 18)

__device__ __forceinline__ unsigned xb_ld(unsigned* p)              { return __hip_atomic_load(p, __ATOMIC_RELAXED, __HIP_MEMORY_SCOPE_AGENT); }
__device__ __forceinline__ unsigned xb_add(unsigned* p, unsigned v) { return __hip_atomic_fetch_add(p, v, __ATOMIC_RELAXED, __HIP_MEMORY_SCOPE_AGENT); }
__device__ __forceinline__ unsigned xb_xcc_id() { return (unsigned)__builtin_amdgcn_s_getreg((3 << 11) | 20) & 0xFu; }
#define XB_SPIN(cond, bar) do { unsigned _sp = 0; while (cond) { __builtin_amdgcn_s_sleep(1); \
    if ((++_sp & 255u) == 0u) { if (xb_ld(&(bar)[XB_TMO])) break; if (_sp > XB_SPIN_CAP) { atomicAdd(&(bar)[XB_TMO], 1u); break; } } } } while (0)

struct XcdBarrier {
    unsigned* bar; unsigned x; unsigned G; int wave;
    volatile LAS unsigned* st;
};

__device__ __forceinline__ XcdBarrier xcd_barrier_post(unsigned* bar, volatile LAS unsigned* st, int wave, unsigned G) {
    XcdBarrier b; b.bar = bar; b.x = xb_xcc_id(); b.st = st; b.G = G; b.wave = wave;
    if (XB_T0(b)) (void)xb_add(&bar[XB_XCNT(b.x)], 1u);
    return b;
}
__device__ __forceinline__ void xcd_barrier_complete(unsigned* bar, unsigned x, const unsigned G, unsigned& nloc, unsigned& nx) {
    unsigned sum, cnt, mine, sp = 0u;
    for (;;) {
        sum = 0u; cnt = 0u; mine = 0u;
#pragma unroll
        for (unsigned j = 0; j < 16; ++j) { const unsigned c = xb_ld(&bar[XB_XCNT(j)]); sum += c; cnt += (c > 0u) ? 1u : 0u; mine = (j == x) ? c : mine; }
        if (sum == G) break;
        __builtin_amdgcn_s_sleep(1);
        if ((++sp & 255u) == 0u) { if (xb_ld(&bar[XB_TMO])) break; if (sp > XB_SPIN_CAP) { atomicAdd(&bar[XB_TMO], 1u); break; } }
    }
    nloc = mine > 0u ? mine : 1u; nx = cnt > 0u ? cnt : 1u;
}

__device__ __forceinline__ void xcd_barrier(const XcdBarrier& b) {
    asm volatile("s_waitcnt vmcnt(0)" ::: "memory");
    __syncthreads();
    if (XB_T0(b)) {
        unsigned* bar = b.bar;
        __builtin_amdgcn_s_waitcnt(0);
        unsigned nloc = b.st[0], nx = b.st[1];
        if (nloc == 0u) { xcd_barrier_complete(bar, b.x, b.G, nloc, nx); b.st[0] = nloc; b.st[1] = nx; }
        const unsigned old = xb_add(&bar[XB_XSUB(b.x)], 1u);
        const unsigned gen = old / nloc;
        if (old + 1u == (gen + 1u) * nloc) {
            __builtin_amdgcn_fence(__ATOMIC_RELEASE, "agent");
            asm volatile("s_waitcnt vmcnt(0)" ::: "memory");
            const unsigned og = xb_add(&bar[XB_TOP], 1u);
            const unsigned tg = og / nx;
            if (og + 1u == (tg + 1u) * nx) xb_add(&bar[XB_TOPGEN], 1u);
            else XB_SPIN(xb_ld(&bar[XB_TOPGEN]) == tg, bar);
            __builtin_amdgcn_fence(__ATOMIC_ACQUIRE, "agent");
            xb_add(&bar[XB_XGEN(b.x)], 1u);
            asm volatile("s_waitcnt vmcnt(0)" ::: "memory");
        } else {
            XB_SPIN(xb_ld(&bar[XB_XGEN(b.x)]) == gen, bar);
            __builtin_amdgcn_fence(__ATOMIC_ACQUIRE, "agent");
            asm volatile("s_waitcnt vmcnt(0)" ::: "memory");
        }
    }
    __syncthreads();
}

typedef __attribute__((address_space(4))) const unsigned char* kptr_t;
template <class T> __device__ __forceinline__ T karg(int byte_off) { return *(const __attribute__((address_space(4))) T*)((kptr_t)__builtin_amdgcn_kernarg_segment_ptr() + byte_off); }
#define KIN(k) karg<const float*>(8 * (k))
#define KOUT() karg<float*>(192)
#define KWS() karg<unsigned char*>(200)
__device__ __forceinline__ int lane_id_opaque() { unsigned z = 0u; asm volatile("" : "+v"(z)); return (int)__builtin_amdgcn_mbcnt_hi(~0u, __builtin_amdgcn_mbcnt_lo(~0u, z)); }
struct Frame {
    LAS unsigned char* lds;
    volatile LAS unsigned* MISC;
    int wave, vcu, G;
};

__device__ __forceinline__ int rowmap(int mode, int moff, int n) {
    if (mode == 0) return n + moff;
    if (mode == 1) return n < DFF ? 256 * (n >> 7) + (n & 127) : 256 * ((n - DFF) >> 7) + 128 + ((n - DFF) & 127);
    return moff + 256 * (n >> 7) + (n & 127);
}
__device__ __forceinline__ void tr_item(const float* W, int ldw, int N, const float* gain, bf16* WT, int ldt, int mode, int moff, LAS float* scr, int item, int lane) {
    const int nblk = N / 32, kb = item / nblk, nb = item % nblk, k0 = 64 * kb, n0 = 32 * nb;
#pragma unroll 8
    for (int i = 0; i < 32; ++i) { const int kk = 2 * i + (lane >> 5); float v = W[(size_t)(k0 + kk) * ldw + n0 + (lane & 31)]; if (gain) v *= gain[k0 + kk]; scr[kk * 33 + (lane & 31)] = v; }
    LDS_WAIT(); asm volatile("" ::: "memory");
    const int c = lane & 7;
#pragma unroll
    for (int j = 0; j < 4; ++j) { const int n = (lane >> 3) + 8 * j; const LAS float* s = scr + (8 * c) * 33 + n;
        v4u o; o.x = pk2(s[0 * 33], s[1 * 33]); o.y = pk2(s[2 * 33], s[3 * 33]); o.z = pk2(s[4 * 33], s[5 * 33]); o.w = pk2(s[6 * 33], s[7 * 33]);
        *(GAS v4u*)(WT + (size_t)rowmap(mode, moff, n0 + n) * ldt + k0 + 8 * c) = o; }
    LDS_WAIT(); asm volatile("" ::: "memory");
}
__device__ __forceinline__ void p0_prologue(Frame& F) {
    LAS float* scr = (LAS float*)(F.lds + F.wave * 16384);
    const int lane = lane_id_opaque();
    const int gw = F.vcu * NWAVES + F.wave, NGW = F.G * NWAVES;
    constexpr int I_QKV = 16 * 48, I_O = 16 * 32, I_FI = 16 * 176, I_FO = 44 * 32, I_RI = 16 * 64, I_G = 4 * 8, I_RO = 16 * 32;
    constexpr int NITEMS = I_QKV + I_O + 2 * I_FI + 2 * I_FO + I_RI + 8 * I_G + I_RO;
    unsigned char* ws = KWS();
    for (int it = gw; it < NITEMS; it += NGW) {
        int r = it;
        if (r < I_QKV) { tr_item(KIN(7), NQKV, NQKV, KIN(6), (bf16*)(ws + WS_WQKV), D, 0, 0, scr, r, lane); continue; } r -= I_QKV;
        if (r < I_O) { tr_item(KIN(8), D, D, nullptr, (bf16*)(ws + WS_WO), D, 0, 0, scr, r, lane); continue; } r -= I_O;
        if (r < I_FI) { tr_item(KIN(21), 2 * DFF, 2 * DFF, KIN(20), (bf16*)(ws + WS_WFI0), D, 1, 0, scr, r, lane); continue; } r -= I_FI;
        if (r < I_FI) { tr_item(KIN(21) + (size_t)D * 2 * DFF, 2 * DFF, 2 * DFF, KIN(20) + D, (bf16*)(ws + WS_WFI1), D, 1, 0, scr, r, lane); continue; } r -= I_FI;
        if (r < I_FO) { tr_item(KIN(22), D, D, nullptr, (bf16*)(ws + WS_WFO0), DFF, 0, 0, scr, r, lane); continue; } r -= I_FO;
        if (r < I_FO) { tr_item(KIN(22) + (size_t)DFF * D, D, D, nullptr, (bf16*)(ws + WS_WFO1), DFF, 0, 0, scr, r, lane); continue; } r -= I_FO;
        if (r < I_RI) { tr_item(KIN(11), 2048, 2048, KIN(10), (bf16*)(ws + WS_WRI), D, 0, 0, scr, r, lane); continue; } r -= I_RI;
        if (r < 8 * I_G) { const int q = r / I_G, blk = q >> 1, ig = q & 1;
            tr_item((ig ? KIN(16) : KIN(14)) + (size_t)blk * 65536, 256, 256, nullptr, (bf16*)(ws + WS_WG), 256, 2, 512 * blk + 128 * ig, scr, r % I_G, lane); continue; } r -= 8 * I_G;
        tr_item(KIN(19), D, D, nullptr, (bf16*)(ws + WS_WRO), D, 0, 0, scr, r, lane);
    }
    bf16* XB = (bf16*)(ws + WS_XB); float* SS = (float*)(ws + WS_SS);
    for (int m = gw; m < M; m += NGW) {
        const float* xrow = m < MP ? KIN(0) + (size_t)m * D : KIN(1) + (size_t)(m - MP) * D;
        const GAS f32x4* xr = (const GAS f32x4*)xrow + lane;
        f32x4 v[4]; float s = 0.f;
#pragma unroll
        for (int j = 0; j < 4; ++j) { v[j] = xr[64 * j]; s += (v[j].x * v[j].x + v[j].y * v[j].y) + (v[j].z * v[j].z + v[j].w * v[j].w); }
        s = wave_sum(s);
        GAS v2u* o8 = (GAS v2u*)(XB + (size_t)m * D) + lane;
#pragma unroll
        for (int j = 0; j < 4; ++j) { v2u w; w.x = pk2(v[j].x, v[j].y); w.y = pk2(v[j].z, v[j].w); o8[64 * j] = w; }
        if (lane < 4) *(GAS f32x4*)(SS + ((size_t)lane * M + m) * 4) = (f32x4){lane == 0 ? s : 0.f, 0.f, 0.f, 0.f};
    }
    {
        const int gt = gw * 64 + lane, NGT = NGW * 64; constexpr int PER_B = 31744 / 4;
        for (int i = gt; i < 2 * DECB * PER_B; i += NGT) {
            const int which = i / (DECB * PER_B), r = i % (DECB * PER_B), b = r / PER_B, e = r % PER_B;
            const float* src = (which ? KIN(3) : KIN(2)) + (size_t)b * 32768 + 1024 + (size_t)e * 4;
            float* dst = KOUT() + (which ? OFF_NV_S : OFF_NK_S) + (size_t)b * 32768 + (size_t)e * 4;
            *(GAS f32x4*)dst = *(const GAS f32x4*)src;
        }
    }
}

using pg8::Unit;
__device__ __forceinline__ float row_rstd(const float* SS, int row) {
    const f32x4 a = *(const f32x4*)(SS + ((size_t)0 * M + row) * 4), b = *(const f32x4*)(SS + ((size_t)1 * M + row) * 4),
                c = *(const f32x4*)(SS + ((size_t)2 * M + row) * 4), d = *(const f32x4*)(SS + ((size_t)3 * M + row) * 4);
    const float s = ((a.x + a.y) + (a.z + a.w)) + ((b.x + b.y) + (b.z + b.w)) + ((c.x + c.y) + (c.z + c.w)) + ((d.x + d.y) + (d.z + d.w));
    return rsqrtf(s * (1.0f / D) + EPS);
}
__device__ __forceinline__ v4u pack8(f32x4 a, f32x4 b) { v4u w; w.x = pk2(a[0], a[1]); w.y = pk2(a[2], a[3]); w.z = pk2(b[0], b[1]); w.w = pk2(b[2], b[3]); return w; }

struct EpiQKV { static constexpr bool PERM = true, AFTER_DRAIN = false;
    __device__ __forceinline__ void operator()(const f32x4 (&acc)[2][2][4][2], const Unit& u, int wr, int wc, int fr, int fq) const {
        unsigned char* ws = KWS(); float* out = KOUT();
        bf16* Q = (bf16*)(ws + WS_Q); bf16* Kb = (bf16*)(ws + WS_K); bf16* Vb = (bf16*)(ws + WS_V); const float* SS = (const float*)(ws + WS_SS);
        const int pm = u.pm, pn = u.pn, cw = wc * 32 + 8 * fq;
#pragma unroll
        for (int ai = 0; ai < 2; ++ai)
#pragma unroll
            for (int m = 0; m < 4; ++m) {
                const int row = pm * 256 + ai * 128 + wr * 64 + m * 16 + fr; const float rs = row_rstd(SS, row);
#pragma unroll
                for (int bj = 0; bj < 2; ++bj) { const int c = bj * 128 + cw; f32x4 v0 = acc[ai][bj][m][0] * rs, v1 = acc[ai][bj][m][1] * rs;
                    if (pn < 4) { v0 = v0 * C2; v1 = v1 * C2; *(v4u*)(Q + (size_t)row * D + pn * 256 + c) = pack8(v0, v1); }
                    else { bf16* dst = (pn == 4 ? Kb : Vb); *(v4u*)(dst + (size_t)row * 256 + c) = pack8(v0, v1);
                        float* o = nullptr;
                        if (pm < 128) { if ((pm & 31) == 31 && ai == 1) o = out + (pn == 4 ? OFF_NK_P : OFF_NV_P) + (size_t)((pm >> 5) * 128 + wr * 64 + m * 16 + fr) * 256 + c; }
                        else { const int rr = row - MP; o = out + (pn == 4 ? OFF_NK_S : OFF_NV_S) + (size_t)((rr >> 2) * 128 + 124 + (rr & 3)) * 256 + c; }
                        if (o) { *(f32x4*)o = v0; *(f32x4*)(o + 4) = v1; } } }
                asm volatile("" ::: "memory");
            }
    }
};
template <bool FIRST> struct EpiRes { static constexpr bool PERM = false, AFTER_DRAIN = false;
    __device__ __forceinline__ void operator()(const f32x4 (&acc)[2][2][4][2], const Unit& u, int wr, int wc, int fr, int fq) const {
        const int pm = u.pm, pn = u.pn;
        unsigned char* ws = KWS(); float* X = KOUT(); bf16* XB = (bf16*)(ws + WS_XB); float* SS = (float*)(ws + WS_SS);
        const float* base = FIRST ? (pm < 128 ? KIN(0) + (size_t)pm * 256 * D : KIN(1) + (size_t)(pm - 128) * 256 * D) : X + (size_t)pm * 256 * D;
#pragma unroll
        for (int ai = 0; ai < 2; ++ai)
#pragma unroll
            for (int m = 0; m < 4; ++m) {
                const int rl = ai * 128 + wr * 64 + m * 16 + fr, row = pm * 256 + rl; float ssq = 0.f;
#pragma unroll
                for (int bj = 0; bj < 2; ++bj)
#pragma unroll
                    for (int n = 0; n < 2; ++n) { const int col = pn * 256 + bj * 128 + wc * 32 + n * 16 + fq * 4;
                        const f32x4 b = *(const f32x4*)(base + (size_t)rl * D + col); const f32x4 v = b + acc[ai][bj][m][n];
                        *(f32x4*)(X + (size_t)row * D + col) = v;
                        v2u w; w.x = pk2(v[0], v[1]); w.y = pk2(v[2], v[3]); *(v2u*)(XB + (size_t)row * D + col) = w;
                        ssq += (v[0] * v[0] + v[1] * v[1]) + (v[2] * v[2] + v[3] * v[3]); }
                ssq += __shfl_xor(ssq, 16); ssq += __shfl_xor(ssq, 32);
                if (fq == 0) SS[((size_t)pn * M + row) * 4 + wc] = ssq;
                asm volatile("" ::: "memory");
            }
    }
};
struct EpiSwiglu { static constexpr bool PERM = true, AFTER_DRAIN = false;
    __device__ __forceinline__ void operator()(const f32x4 (&acc)[2][2][4][2], const Unit& u, int wr, int wc, int fr, int fq) const {
        unsigned char* ws = KWS(); bf16* H = (bf16*)(ws + WS_H); const float* SS = (const float*)(ws + WS_SS);
        const int pm = u.pm, pn = u.pn, c = pn * 128 + wc * 32 + 8 * fq;
#pragma unroll
        for (int ai = 0; ai < 2; ++ai)
#pragma unroll
            for (int m = 0; m < 4; ++m) {
                const int row = pm * 256 + ai * 128 + wr * 64 + m * 16 + fr; const float rs = row_rstd(SS, row);
                f32x4 hv[2];
#pragma unroll
                for (int n = 0; n < 2; ++n)
#pragma unroll
                    for (int e = 0; e < 4; ++e) { const float g = acc[ai][0][m][n][e] * rs, uu = acc[ai][1][m][n][e] * rs; hv[n][e] = g * rcpf_(1.0f + ex2(-g * LOG2E)) * uu; }
                *(v4u*)(H + (size_t)row * DFF + c) = pack8(hv[0], hv[1]);
                asm volatile("" ::: "memory");
            }
    }
};
struct EpiRecIn { static constexpr bool PERM = true, AFTER_DRAIN = false;
    __device__ __forceinline__ void operator()(const f32x4 (&acc)[2][2][4][2], const Unit& u, int wr, int wc, int fr, int fq) const {
        unsigned char* ws = KWS(); float* out = KOUT(); bf16* GG = (bf16*)(ws + WS_GG); bf16* XBC = (bf16*)(ws + WS_XBC); const float* SS = (const float*)(ws + WS_SS);
        const int pm = u.pm, pn = u.pn, cw = wc * 32 + 8 * fq;
#pragma unroll
        for (int ai = 0; ai < 2; ++ai)
#pragma unroll
            for (int m = 0; m < 4; ++m) {
                const int row = pm * 256 + ai * 128 + wr * 64 + m * 16 + fr; const float rs = row_rstd(SS, row);
#pragma unroll
                for (int bj = 0; bj < 2; ++bj) { const int c = bj * 128 + cw; f32x4 v0 = acc[ai][bj][m][0] * rs, v1 = acc[ai][bj][m][1] * rs;
                    if (pn < 4) {
#pragma unroll
                        for (int e = 0; e < 4; ++e) { float g = v0[e]; float z = 0.7978845608028654f * (g + 0.044715f * g * g * g); v0[e] = g * rcpf_(1.0f + ex2(-2.0f * LOG2E * z));
                            g = v1[e]; z = 0.7978845608028654f * (g + 0.044715f * g * g * g); v1[e] = g * rcpf_(1.0f + ex2(-2.0f * LOG2E * z)); }
                        *(v4u*)(GG + (size_t)row * D + pn * 256 + c) = pack8(v0, v1);
                    } else { const int col = (pn - 4) * 256 + c;
                        *(v4u*)(XBC + (size_t)row * D + col) = pack8(v0, v1);
                        float* o = nullptr;
                        if (pm < 128) { if ((pm & 31) == 31 && ai == 1 && wr == 1 && m == 3 && fr >= 13) o = out + OFF_NC_P + (size_t)((pm >> 5) * 3 + fr - 13) * D + col; }
                        else { const int rr = row - MP; if ((rr & 3) >= 1) o = out + OFF_NC_S + (size_t)((rr >> 2) * 3 + (rr & 3) - 1) * D + col; }
                        if (o) { *(f32x4*)o = v0; *(f32x4*)(o + 4) = v1; } } }
                asm volatile("" ::: "memory");
            }
    }
};
struct EpiGates { static constexpr bool PERM = true, AFTER_DRAIN = false;
    __device__ __forceinline__ void operator()(const f32x4 (&acc)[2][2][4][2], const Unit& u, int wr, int wc, int fr, int fq) const {
        unsigned char* ws = KWS(); const bf16* XC = (const bf16*)(ws + WS_XC); _Float16* LA = (_Float16*)(ws + WS_LA); _Float16* BB = (_Float16*)(ws + WS_BB);
        const float* brg = KIN(15); const float* big = KIN(17); const float* lam = KIN(18);
        const int pm = u.pm, pn = u.pn, d0 = (pn >> 1) * 256 + (pn & 1) * 128 + wc * 32 + 8 * fq;
        float br[8], bi[8], c8[8];
#pragma unroll
        for (int e = 0; e < 8; ++e) { br[e] = brg[d0 + e]; bi[e] = big[d0 + e]; c8[e] = -8.0f * LOG2E * log1pf(__expf(-lam[d0 + e])); }
#pragma unroll
        for (int ai = 0; ai < 2; ++ai)
#pragma unroll
            for (int m = 0; m < 4; ++m) {
                const int row = pm * 256 + ai * 128 + wr * 64 + m * 16 + fr;
                const v4u xw = *(const v4u*)(XC + (size_t)row * D + d0);
                float xc[8] = {bflo(xw.x), bfhi(xw.x), bflo(xw.y), bfhi(xw.y), bflo(xw.z), bfhi(xw.z), bflo(xw.w), bfhi(xw.w)};
                h16x8 la8, bb8;
#pragma unroll
                for (int e = 0; e < 8; ++e) {
                    const float rp = acc[ai][0][m][e >> 2][e & 3] + br[e], ip = acc[ai][1][m][e >> 2][e & 3] + bi[e];
                    const float r = rcpf_(1.0f + ex2(-rp * LOG2E)), ig = rcpf_(1.0f + ex2(-ip * LOG2E));
                    const float la2 = r * c8[e]; const float a2 = ex2(2.0f * la2); const float b = sqrtf(fmaxf(1.0f - a2, 0.0f)) * (ig * xc[e]);
                    la8[e] = (_Float16)la2; bb8[e] = (_Float16)b; }
                *(h16x8*)(LA + (size_t)row * D + d0) = la8; *(h16x8*)(BB + (size_t)row * D + d0) = bb8;
                asm volatile("" ::: "memory");
            }
    }
};

__device__ __forceinline__ int crow(int r, int hi) { return (r & 3) + 8 * (r >> 2) + 4 * hi; }
typedef short v4i16_t __attribute__((ext_vector_type(4)));
__device__ __forceinline__ s16x4 vtr(LAS const unsigned char* p) { return __builtin_bit_cast(s16x4, __builtin_amdgcn_ds_read_tr16_b64_v4i16((LAS v4i16_t*)p)); }
constexpr int AT_KS = 0, AT_VS = 27648, AT_WSF = 55296, AT_ROWB = 144;
__device__ __forceinline__ void attn_prompt_unit(Frame& F, int b, int g, int qb, const bf16* Q, const bf16* Kb, const bf16* Vb, bf16* O, const float* sinks) {
    const int lane = lane_id_opaque(), wid = F.wave, tid = wid * 64 + lane, r32 = lane & 31, hi = lane >> 5;
    LAS unsigned char* lds = F.lds;
    const int t0 = qb * 64 - 128; const size_t rowbase = (size_t)b * SEQ;
#pragma unroll
    for (int i = 0; i < 3; ++i) { const int idx = tid + 512 * i, r = idx >> 3, ch = idx & 7, t = t0 + r;
        v4u kv = (v4u){0u, 0u, 0u, 0u}, vv = (v4u){0u, 0u, 0u, 0u};
        if (t >= 0) { kv = *(const v4u*)(Kb + (rowbase + t) * 256 + g * 64 + ch * 8); vv = *(const v4u*)(Vb + (rowbase + t) * 256 + g * 64 + ch * 8); }
        *(LAS v4u*)(lds + AT_KS + r * AT_ROWB + ch * 16) = kv; *(LAS v4u*)(lds + AT_VS + r * AT_ROWB + ch * 16) = vv; }
    const int h = 4 * g + (wid >> 1), s = wid & 1, tq0 = qb * 64 + 32 * s;
    bf16x8 qr[4];
    { const bf16* qrow = Q + (rowbase + tq0 + r32) * D + h * 64 + hi * 8;
#pragma unroll
      for (int d0 = 0; d0 < 4; ++d0) qr[d0] = *(const bf16x8*)(qrow + d0 * 16); }
    __syncthreads();
    f32x16 p[5];
#pragma unroll
    for (int c = 0; c < 5; ++c) { f32x16 a = {};
#pragma unroll
        for (int d0 = 0; d0 < 4; ++d0) { const bf16x8 kf = *(const LAS bf16x8*)(lds + AT_KS + (32 * s + 32 * c + r32) * AT_ROWB + (d0 * 16 + hi * 8) * 2); a = __builtin_amdgcn_mfma_f32_32x32x16_bf16(kf, qr[d0], a, 0, 0, 0); }
        p[c] = a; }
    const float slope2 = ex2(-0.5f * (float)(h + 1)) * LOG2E, sink2 = sinks[h] * LOG2E;
    int base = r32 - 4 * hi + 128; asm volatile("" : "+v"(base));
    const float sb = slope2 * (float)base; const int kmin = 128 - tq0 - 4 * hi; const bool head = tq0 < 128;
    float mx = sink2;
#pragma unroll
    for (int c = 0; c < 5; ++c)
#pragma unroll
        for (int r = 0; r < 16; ++r) { const int kc = 32 * c + (r & 3) + 8 * (r >> 2);
            float x = fmaf(slope2, (float)kc, p[c][r]) - sb;
            bool valid = true;
            if (c == 0) valid = kc >= base - 128;
            if (c == 4) valid = kc <= base;
            if (head) valid = valid && (kc >= kmin);
            x = valid ? x : -1e30f; p[c][r] = x; mx = fmaxf(mx, x); }
    mx = fmaxf(mx, __shfl_xor(mx, 32));
    float l = 0.f;
#pragma unroll
    for (int c = 0; c < 5; ++c)
#pragma unroll
        for (int r = 0; r < 16; ++r) { const float e = ex2(p[c][r] - mx); p[c][r] = e; l += e; }
    l += __shfl_xor(l, 32); l += ex2(sink2 - mx);
    f32x16 o[2]; o[0] = f32x16{}; o[1] = f32x16{};
    const int vlane = (4 * hi + ((lane & 15) >> 2)) * AT_ROWB + 32 * ((lane >> 4) & 1) + 8 * (lane & 3);
#pragma unroll
    for (int c = 0; c < 5; ++c)
#pragma unroll
        for (int s2 = 0; s2 < 2; ++s2) {
            v4u pw; pw.x = pk2(p[c][8 * s2 + 0], p[c][8 * s2 + 1]); pw.y = pk2(p[c][8 * s2 + 2], p[c][8 * s2 + 3]); pw.z = pk2(p[c][8 * s2 + 4], p[c][8 * s2 + 5]); pw.w = pk2(p[c][8 * s2 + 6], p[c][8 * s2 + 7]);
            const bf16x8 pa = __builtin_bit_cast(bf16x8, pw);
            const int krow0 = 32 * s + 32 * c + 16 * s2;
#pragma unroll
            for (int dh = 0; dh < 2; ++dh) {
                const s16x4 vlo = vtr(lds + AT_VS + krow0 * AT_ROWB + vlane + 64 * dh), vhi = vtr(lds + AT_VS + (krow0 + 8) * AT_ROWB + vlane + 64 * dh);
                const bf16x8 vf = (bf16x8){vlo[0], vlo[1], vlo[2], vlo[3], vhi[0], vhi[1], vhi[2], vhi[3]};
                o[dh] = __builtin_amdgcn_mfma_f32_32x32x16_bf16(pa, vf, o[dh], 0, 0, 0); }
        }
    LAS float* wsf = (LAS float*)(lds + AT_WSF) + wid * 32;
    if (hi == 0) wsf[r32] = 1.0f / l;
    LDS_WAIT(); asm volatile("" ::: "memory");
    bf16* Ow = O + (rowbase + tq0) * D + h * 64 + r32;
#pragma unroll
    for (int r = 0; r < 16; ++r) { const int q = crow(r, hi); const float inv = wsf[q];
        Ow[(size_t)q * D] = (bf16)f2bf(o[0][r] * inv); Ow[(size_t)q * D + 32] = (bf16)f2bf(o[1][r] * inv); }
    __syncthreads();
}
__device__ __forceinline__ void attn_sample_task(Frame& F, int b, int g, const bf16* Q, const bf16* Kb, const bf16* Vb, bf16* O, const float* ck, const float* cv, const float* sinks) {
    const int lane = lane_id_opaque();
    LAS float* Qs = (LAS float*)(F.lds + F.wave * 16384); LAS float* Pt = Qs + 1024;
#pragma unroll
    for (int i = 0; i < 16; ++i) Qs[i * 64 + lane] = bf2f(Q[(size_t)(MP + 4 * b + (i >> 2)) * D + (4 * g + (i & 3)) * 64 + lane]);
    LDS_WAIT(); asm volatile("" ::: "memory");
    for (int j = 0; j < 3; ++j) { const int si = lane + 64 * j;
        if (si < 132) {
            float kv[64];
            if (si < 128) { const f32x4* kp = (const f32x4*)(ck + ((size_t)(b * 128 + si) * 4 + g) * 64);
#pragma unroll
                for (int e = 0; e < 16; ++e) { const f32x4 v = kp[e]; kv[4 * e] = v.x; kv[4 * e + 1] = v.y; kv[4 * e + 2] = v.z; kv[4 * e + 3] = v.w; } }
            else { const v4u* kp = (const v4u*)(Kb + (size_t)(MP + 4 * b + si - 128) * 256 + g * 64);
#pragma unroll
                for (int e = 0; e < 8; ++e) { const v4u w = kp[e]; kv[8 * e] = bflo(w.x); kv[8 * e + 1] = bfhi(w.x); kv[8 * e + 2] = bflo(w.y); kv[8 * e + 3] = bfhi(w.y); kv[8 * e + 4] = bflo(w.z); kv[8 * e + 5] = bfhi(w.z); kv[8 * e + 6] = bflo(w.w); kv[8 * e + 7] = bfhi(w.w); } }
#pragma unroll 1
            for (int i = 0; i < 16; ++i) { const int t = i >> 2, h = 4 * g + (i & 3); float dt = 0.f;
#pragma unroll
                for (int e = 0; e < 16; ++e) { const f32x4 qv = *(const LAS f32x4*)(Qs + i * 64 + 4 * e); dt += kv[4 * e] * qv.x + kv[4 * e + 1] * qv.y + kv[4 * e + 2] * qv.z + kv[4 * e + 3] * qv.w; }
                const int dist = t - si + 128; const float slope2 = ex2(-0.5f * (float)(h + 1)) * LOG2E;
                Pt[si * 16 + i] = (dist >= 0 && dist <= 128) ? dt - slope2 * (float)dist : -1e30f; }
        }
    }
    LDS_WAIT(); asm volatile("" ::: "memory");
    float linv[16];
#pragma unroll
    for (int i = 0; i < 16; ++i) { const float sink2 = sinks[4 * g + (i & 3)] * LOG2E;
        float x0 = Pt[lane * 16 + i], x1 = Pt[(lane + 64) * 16 + i], x2 = lane < 4 ? Pt[(lane + 128) * 16 + i] : -1e30f;
        const float mx = fmaxf(wave_max(fmaxf(fmaxf(x0, x1), x2)), sink2);
        x0 = ex2(x0 - mx); x1 = ex2(x1 - mx); x2 = ex2(x2 - mx);
        const float l = wave_sum(x0 + x1 + x2) + ex2(sink2 - mx); linv[i] = 1.0f / l;
        Pt[lane * 16 + i] = x0; Pt[(lane + 64) * 16 + i] = x1; if (lane < 4) Pt[(lane + 128) * 16 + i] = x2; }
    LDS_WAIT(); asm volatile("" ::: "memory");
    float o[16];
#pragma unroll
    for (int i = 0; i < 16; ++i) o[i] = 0.f;
#pragma unroll 4
    for (int si = 0; si < 132; ++si) {
        const float v = si < 128 ? cv[((size_t)(b * 128 + si) * 4 + g) * 64 + lane] : bf2f(Vb[(size_t)(MP + 4 * b + si - 128) * 256 + g * 64 + lane]);
#pragma unroll
        for (int q4 = 0; q4 < 4; ++q4) { const f32x4 pv = *(const LAS f32x4*)(Pt + si * 16 + 4 * q4); o[4 * q4] += pv.x * v; o[4 * q4 + 1] += pv.y * v; o[4 * q4 + 2] += pv.z * v; o[4 * q4 + 3] += pv.w * v; }
    }
#pragma unroll
    for (int i = 0; i < 16; ++i) O[(size_t)(MP + 4 * b + (i >> 2)) * D + (4 * g + (i & 3)) * 64 + lane] = (bf16)f2bf(o[i] * linv[i]);
    LDS_WAIT(); asm volatile("" ::: "memory");
}
__device__ __forceinline__ void attn_phase(Frame& F) {
    unsigned char* ws = KWS();
    const bf16* Q = (const bf16*)(ws + WS_Q); const bf16* Kb = (const bf16*)(ws + WS_K); const bf16* Vb = (const bf16*)(ws + WS_V); bf16* O = (bf16*)(ws + WS_O);
    for (int task = F.wave * F.G + (int)blockIdx.x; task < DECB * NKV; task += NWAVES * F.G) attn_sample_task(F, task >> 2, task & 3, Q, Kb, Vb, O, KIN(2), KIN(3), KIN(9));
    __syncthreads();
    for (int u = F.vcu; u < BATCH * 128 * NKV; u += F.G) { const int g = u & 3, qb = (u >> 2) & 127, b = u >> 9; attn_prompt_unit(F, b, g, qb, Q, Kb, Vb, O, KIN(9)); }
}

__device__ __forceinline__ void conv_phase(Frame& F) {
    unsigned char* ws = KWS(); const bf16* XBC = (const bf16*)(ws + WS_XBC); bf16* XC = (bf16*)(ws + WS_XC);
    const float* cw = KIN(12); const float* cb = KIN(13);
    const int tid = F.wave * 64 + lane_id_opaque();
    const int dg = tid & 127, d0 = 8 * dg, rr = tid >> 7;
    float w[4][8], bias[8];
#pragma unroll
    for (int e = 0; e < 8; ++e) { bias[e] = cb[d0 + e];
#pragma unroll
        for (int j = 0; j < 4; ++j) w[j][e] = cw[j * D + d0 + e]; }
    for (int u = F.vcu; u < MP / 64; u += F.G) {
        const int row0 = (u * 4 + rr) * 16, t0 = row0 & (SEQ - 1);
        float h0[8], h1[8], h2[8];
#pragma unroll
        for (int e = 0; e < 8; ++e) { h0[e] = 0.f; h1[e] = 0.f; h2[e] = 0.f; }
        if (t0 != 0) {
            const v4u a = *(const v4u*)(XBC + (size_t)(row0 - 3) * D + d0), b = *(const v4u*)(XBC + (size_t)(row0 - 2) * D + d0), c = *(const v4u*)(XBC + (size_t)(row0 - 1) * D + d0);
            h0[0] = bflo(a.x); h0[1] = bfhi(a.x); h0[2] = bflo(a.y); h0[3] = bfhi(a.y); h0[4] = bflo(a.z); h0[5] = bfhi(a.z); h0[6] = bflo(a.w); h0[7] = bfhi(a.w);
            h1[0] = bflo(b.x); h1[1] = bfhi(b.x); h1[2] = bflo(b.y); h1[3] = bfhi(b.y); h1[4] = bflo(b.z); h1[5] = bfhi(b.z); h1[6] = bflo(b.w); h1[7] = bfhi(b.w);
            h2[0] = bflo(c.x); h2[1] = bfhi(c.x); h2[2] = bflo(c.y); h2[3] = bfhi(c.y); h2[4] = bflo(c.z); h2[5] = bfhi(c.z); h2[6] = bflo(c.w); h2[7] = bfhi(c.w);
        }
#pragma unroll 4
        for (int i = 0; i < 16; ++i) {
            const v4u cwd = *(const v4u*)(XBC + (size_t)(row0 + i) * D + d0);
            float cur[8] = {bflo(cwd.x), bfhi(cwd.x), bflo(cwd.y), bfhi(cwd.y), bflo(cwd.z), bfhi(cwd.z), bflo(cwd.w), bfhi(cwd.w)};
            float xc[8];
#pragma unroll
            for (int e = 0; e < 8; ++e) { xc[e] = bias[e] + w[0][e] * h0[e] + w[1][e] * h1[e] + w[2][e] * h2[e] + w[3][e] * cur[e]; h0[e] = h1[e]; h1[e] = h2[e]; h2[e] = cur[e]; }
            v4u o; o.x = pk2(xc[0], xc[1]); o.y = pk2(xc[2], xc[3]); o.z = pk2(xc[4], xc[5]); o.w = pk2(xc[6], xc[7]);
            *(v4u*)(XC + (size_t)(row0 + i) * D + d0) = o;
        }
    }
    const float* cs = KIN(4);
    for (int u = F.vcu; u < DECB / 4; u += F.G) {
        const int b = u * 4 + rr; const int row0 = MP + 4 * b;
        float h0[8], h1[8], h2[8];
        { const f32x4* p0 = (const f32x4*)(cs + ((size_t)b * 3 + 0) * D + d0); const f32x4* p1 = (const f32x4*)(cs + ((size_t)b * 3 + 1) * D + d0); const f32x4* p2 = (const f32x4*)(cs + ((size_t)b * 3 + 2) * D + d0);
#pragma unroll
          for (int q = 0; q < 2; ++q) { const f32x4 a = p0[q], bb = p1[q], c = p2[q];
#pragma unroll
              for (int e = 0; e < 4; ++e) { h0[4 * q + e] = a[e]; h1[4 * q + e] = bb[e]; h2[4 * q + e] = c[e]; } } }
#pragma unroll
        for (int i = 0; i < 4; ++i) {
            const v4u cwd = *(const v4u*)(XBC + (size_t)(row0 + i) * D + d0);
            float cur[8] = {bflo(cwd.x), bfhi(cwd.x), bflo(cwd.y), bfhi(cwd.y), bflo(cwd.z), bfhi(cwd.z), bflo(cwd.w), bfhi(cwd.w)};
            float xc[8];
#pragma unroll
            for (int e = 0; e < 8; ++e) { xc[e] = bias[e] + w[0][e] * h0[e] + w[1][e] * h1[e] + w[2][e] * h2[e] + w[3][e] * cur[e]; h0[e] = h1[e]; h1[e] = h2[e]; h2[e] = cur[e]; }
            v4u o; o.x = pk2(xc[0], xc[1]); o.y = pk2(xc[2], xc[3]); o.z = pk2(xc[4], xc[5]); o.w = pk2(xc[6], xc[7]);
            *(v4u*)(XC + (size_t)(row0 + i) * D + d0) = o;
        }
    }
}

constexpr int SCH = 128, NSCH = SEQ / SCH;
__device__ __forceinline__ void scan1_phase(Frame& F) {
    unsigned char* ws = KWS(); const _Float16* LA = (const _Float16*)(ws + WS_LA); const _Float16* BB = (const _Float16*)(ws + WS_BB);
    float* SLA = (float*)(ws + WS_SLA); float* HT = (float*)(ws + WS_HT);
    const int d = 2 * (F.wave * 64 + lane_id_opaque());
    for (int u = F.vcu; u < BATCH * NSCH; u += F.G) {
        const size_t row0 = (size_t)u * SCH;
        float s0 = 0.f, s1 = 0.f, h0 = 0.f, h1 = 0.f;
#pragma unroll 8
        for (int i = 0; i < SCH; ++i) { const h16x2 la = *(const h16x2*)(LA + (row0 + i) * D + d), bb = *(const h16x2*)(BB + (row0 + i) * D + d);
            const float l0 = (float)la[0], l1 = (float)la[1]; s0 += l0; s1 += l1; h0 = ex2(l0) * h0 + (float)bb[0]; h1 = ex2(l1) * h1 + (float)bb[1]; }
        *(f32x2*)(SLA + (size_t)u * D + d) = (f32x2){s0, s1}; *(f32x2*)(HT + (size_t)u * D + d) = (f32x2){h0, h1};
    }
}
__device__ __forceinline__ void scan2_phase(Frame& F) {
    unsigned char* ws = KWS(); const _Float16* LA = (const _Float16*)(ws + WS_LA); const _Float16* BB = (const _Float16*)(ws + WS_BB);
    const bf16* GG = (const bf16*)(ws + WS_GG); bf16* A2 = (bf16*)(ws + WS_XBC);
    const float* SLA = (const float*)(ws + WS_SLA); const float* HT = (const float*)(ws + WS_HT);
    const int d = 2 * (F.wave * 64 + lane_id_opaque());
    for (int u = F.vcu; u < BATCH * NSCH + DECB; u += F.G) {
        float h0, h1; size_t row0; int nrow;
        if (u < BATCH * NSCH) {
            const int b = u / NSCH, c = u % NSCH; h0 = 0.f; h1 = 0.f;
#pragma unroll 4
            for (int cc = 0; cc < c; ++cc) { const f32x2 sl = *(const f32x2*)(SLA + (size_t)(b * NSCH + cc) * D + d), ht = *(const f32x2*)(HT + (size_t)(b * NSCH + cc) * D + d);
                h0 = ex2(sl[0]) * h0 + ht[0]; h1 = ex2(sl[1]) * h1 + ht[1]; }
            row0 = (size_t)u * SCH; nrow = SCH;
        } else { const int b = u - BATCH * NSCH; const f32x2 hh = *(const f32x2*)(KIN(5) + (size_t)b * D + d); h0 = hh[0]; h1 = hh[1]; row0 = (size_t)MP + 4 * b; nrow = 4; }
#pragma unroll 4
        for (int i = 0; i < nrow; ++i) { const size_t idx = (row0 + i) * D + d; const h16x2 la = *(const h16x2*)(LA + idx), bb = *(const h16x2*)(BB + idx); const unsigned gw = *(const unsigned*)(GG + idx);
            h0 = ex2((float)la[0]) * h0 + (float)bb[0]; h1 = ex2((float)la[1]) * h1 + (float)bb[1];
            *(unsigned*)(A2 + idx) = pk2(h0 * bflo(gw), h1 * bfhi(gw)); }
        if (u < BATCH * NSCH) { if ((u % NSCH) == NSCH - 1) *(f32x2*)(KOUT() + OFF_NH_P + (size_t)(u / NSCH) * D + d) = (f32x2){h0, h1}; }
        else *(f32x2*)(KOUT() + OFF_NH_S + (size_t)(u - BATCH * NSCH) * D + d) = (f32x2){h0, h1};
    }
}
__device__ __forceinline__ void final_norm_phase(Frame& F) {
    const float* SS = (const float*)(KWS() + WS_SS); const float* g = KIN(23);
    const int lane = lane_id_opaque();
    const int gw = F.vcu * NWAVES + F.wave, NGW = F.G * NWAVES;
    f32x4 gv[4];
#pragma unroll
    for (int j = 0; j < 4; ++j) gv[j] = *(const f32x4*)(g + 4 * lane + 256 * j);
    for (int m = gw; m < M; m += NGW) {
        float s = lane < 16 ? SS[((size_t)(lane >> 2) * M + m) * 4 + (lane & 3)] : 0.f;
        s = wave_sum(s); const float rs = rsqrtf(s * (1.0f / D) + EPS);
        GAS f32x4* xr = (GAS f32x4*)(KOUT() + (size_t)m * D) + lane;
#pragma unroll
        for (int j = 0; j < 4; ++j) { f32x4 v = xr[64 * j]; v = v * rs * gv[j]; xr[64 * j] = v; }
    }
}

struct Args { const float* in[24]; float* out; unsigned char* ws; int ph_lo, ph_hi; };
constexpr int N_PHASES = 15;
__global__ void __launch_bounds__(NWAVES * 64, 2) mega_fwd(Args  ) {
    extern __shared__ __attribute__((aligned(16))) unsigned char lds[];
    Frame F;
    F.lds = (LAS unsigned char*)lds; F.MISC = (volatile LAS unsigned*)(F.lds + MISC_OFF);
    { const int tid0 = threadIdx.x; F.wave = __builtin_amdgcn_readfirstlane(tid0 >> 6);
      for (int u = tid0; u < (LDS_BYTES - LDSCTL_OFF) / 4; u += NWAVES * 64) ((LAS unsigned*)(F.lds + LDSCTL_OFF))[u] = 0u; }
    F.G = gridDim.x; { const int bx = blockIdx.x; F.vcu = (F.G % 8 == 0) ? (bx % 8) * (F.G / 8) + bx / 8 : bx; }
    __syncthreads();
    const int lo = karg<int>(208), hi = karg<int>(212);
    const bool use_bar = (hi - lo) > 1;
    XcdBarrier bar; bar.bar = (unsigned*)(KWS() + WS_CTL) + CW_BAR; bar.x = 0; bar.st = nullptr; bar.G = 0; bar.wave = F.wave;
    if (use_bar) bar = xcd_barrier_post((unsigned*)(KWS() + WS_CTL) + CW_BAR, F.MISC + 8, F.wave, (unsigned)F.G);
#define IN(k) (lo <= (k) && (k) < hi)
#define SEAM(k) do { if (IN(k) && IN((k) + 1)) xcd_barrier(bar); } while (0)
#define WSP(T, off) ((T)(KWS() + (off)))
    const int bx = (int)blockIdx.x;
    if (IN(0)) { p0_prologue(F); } SEAM(0);
    if (IN(1)) { pg8::Gemm g{WSP(const bf16*, WS_XB), WSP(const bf16*, WS_WQKV), D, D, D, 0, 0}; pg8::StaticOrder S; S.init(M, NQKV, F.G, bx);
        EpiQKV E;
        pg8::gemm_phase<EpiQKV, pg8::StaticOrder, true, true>(F.lds, F.wave, g, S, E); } SEAM(1);
    if (IN(2)) { attn_phase(F); } SEAM(2);
    if (IN(3)) { pg8::Gemm g{WSP(const bf16*, WS_O), WSP(const bf16*, WS_WO), D, D, D, 0, 0}; pg8::StaticOrder S; S.init(M, D, F.G, bx);
        EpiRes<true> E;
        pg8::gemm_phase<EpiRes<true>, pg8::StaticOrder, true, true>(F.lds, F.wave, g, S, E); } SEAM(3);
    if (IN(4)) { pg8::Gemm g{WSP(const bf16*, WS_XB), WSP(const bf16*, WS_WFI0), D, D, D, 0, 0}; pg8::StaticOrder S; S.init(M, 2 * DFF, F.G, bx);
        EpiSwiglu E;
        pg8::gemm_phase<EpiSwiglu, pg8::StaticOrder, true, true>(F.lds, F.wave, g, S, E); } SEAM(4);
    if (IN(5)) { pg8::Gemm g{WSP(const bf16*, WS_H), WSP(const bf16*, WS_WFO0), DFF, DFF, DFF, 0, 0}; pg8::StaticOrder S; S.init(M, D, F.G, bx);
        EpiRes<false> E;
        pg8::gemm_phase<EpiRes<false>, pg8::StaticOrder, true, true>(F.lds, F.wave, g, S, E); } SEAM(5);
    if (IN(6)) { pg8::Gemm g{WSP(const bf16*, WS_XB), WSP(const bf16*, WS_WRI), D, D, D, 0, 0}; pg8::StaticOrder S; S.init(M, 2048, F.G, bx);
        EpiRecIn E;
        pg8::gemm_phase<EpiRecIn, pg8::StaticOrder, true, true>(F.lds, F.wave, g, S, E); } SEAM(6);
    if (IN(7)) { conv_phase(F); } SEAM(7);
    if (IN(8)) { pg8::Gemm g{WSP(const bf16*, WS_XC), WSP(const bf16*, WS_WG), 256, D, 256, 1, 512}; pg8::StaticOrder S; S.init(M, 2048, F.G, bx);
        EpiGates E;
        pg8::gemm_phase<EpiGates, pg8::StaticOrder, true, true>(F.lds, F.wave, g, S, E); } SEAM(8);
    if (IN(9)) { scan1_phase(F); } SEAM(9);
    if (IN(10)) { scan2_phase(F); } SEAM(10);
    if (IN(11)) { pg8::Gemm g{WSP(const bf16*, WS_XBC), WSP(const bf16*, WS_WRO), D, D, D, 0, 0}; pg8::StaticOrder S; S.init(M, D, F.G, bx);
        EpiRes<false> E;
        pg8::gemm_phase<EpiRes<false>, pg8::StaticOrder, true, true>(F.lds, F.wave, g, S, E); } SEAM(11);
    if (IN(12)) { pg8::Gemm g{WSP(const bf16*, WS_XB), WSP(const bf16*, WS_WFI1), D, D, D, 0, 0}; pg8::StaticOrder S; S.init(M, 2 * DFF, F.G, bx);
        EpiSwiglu E;
        pg8::gemm_phase<EpiSwiglu, pg8::StaticOrder, true, true>(F.lds, F.wave, g, S, E); } SEAM(12);
    if (IN(13)) { pg8::Gemm g{WSP(const bf16*, WS_H), WSP(const bf16*, WS_WFO1), DFF, DFF, DFF, 0, 0}; pg8::StaticOrder S; S.init(M, D, F.G, bx);
        EpiRes<false> E;
        pg8::gemm_phase<EpiRes<false>, pg8::StaticOrder, true, true>(F.lds, F.wave, g, S, E); } SEAM(13);
    if (IN(14)) { final_norm_phase(F); }
#undef IN
#undef SEAM
#undef WSP
}

#ifndef MK_ONE_LAUNCH
#define MK_ONE_LAUNCH 0
#endif
extern "C" void kernel_launch(void* const* d_in, const int* in_sizes, int n_in, void* d_out, int out_size, void* d_ws, size_t ws_size, hipStream_t stream) {
    static int grid = 0;
    if (grid == 0) {
        if (n_in != 24 || ws_size < WS_END) { fprintf(stderr, "kernel_launch: unexpected n_in %d / ws %zu\n", n_in, ws_size); grid = -1; return; }
        int dev = 0, cus = 0, per_cu = 0;
        if (hipGetDevice(&dev) != hipSuccess || hipDeviceGetAttribute(&cus, hipDeviceAttributeMultiprocessorCount, dev) != hipSuccess) { grid = -1; return; }
        if (hipFuncSetAttribute((const void*)mega_fwd, hipFuncAttributeMaxDynamicSharedMemorySize, LDS_BYTES) != hipSuccess) { fprintf(stderr, "kernel_launch: hipFuncSetAttribute failed\n"); grid = -1; return; }
        if (hipOccupancyMaxActiveBlocksPerMultiprocessor(&per_cu, (const void*)mega_fwd, NWAVES * 64, LDS_BYTES) != hipSuccess || per_cu < 1) { fprintf(stderr, "kernel_launch: occupancy query says %d\n", per_cu); (void)hipGetLastError(); grid = -1; return; }
        grid = cus;
    }
    if (grid < 0) return;
    (void)hipMemsetAsync((char*)d_ws + WS_CTL, 0, CTL_ZERO_BYTES, stream);
    Args a{};
    for (int i = 0; i < 24; ++i) a.in[i] = (const float*)d_in[i];
    a.out = (float*)d_out; a.ws = (unsigned char*)d_ws;
#if MK_ONE_LAUNCH
    a.ph_lo = 0; a.ph_hi = N_PHASES;
    hipLaunchKernelGGL(mega_fwd, dim3(grid), dim3(NWAVES * 64), LDS_BYTES, stream, a);
#else
    for (int p = 0; p < N_PHASES; ++p) { a.ph_lo = p; a.ph_hi = p + 1; hipLaunchKernelGGL(mega_fwd, dim3(grid), dim3(NWAVES * 64), LDS_BYTES, stream, a); }
#endif
}
```

```cpp
#include <hip/hip_runtime.h>
#include <cstdio>
#include <cstdint>
namespace pg8 {
#define PG8_LAS __attribute__((address_space(3)))
typedef unsigned short bf16_t;
typedef short bf16x8 __attribute__((ext_vector_type(8)));
typedef float f32x4 __attribute__((ext_vector_type(4)));
typedef unsigned u32x4 __attribute__((ext_vector_type(4)));
constexpr int BM = 256, BK = 64, HALF = 128, HTB = HALF * BK * 2  , STAGE_BYTES = 8 * HTB, NXCD = 8;

__host__ __device__ __forceinline__ int lds_byte(int r, int c) { const int st = (r >> 4) * 2 + (c >> 5), rr = r & 15, cc = c & 31, ob = rr * 64 + cc * 2; return st * 1024 + (ob ^ (((ob >> 9) & 1) << 5)); }
__host__ __device__ __forceinline__ void stage_rc(int b, int& R, int& C) { const int st = b / 1024, sb = b % 1024, swz = sb ^ (((sb >> 9) & 1) << 5); R = (st >> 1) * 16 + swz / 64; C = (st & 1) * 32 + (swz % 64) / 2; }
__host__ __device__ __forceinline__ int perm32(int rho) { const int n = rho >> 4, i = rho & 15; return 8 * (i >> 2) + 4 * n + (i & 3); }

struct Unit { int pm, pn; };
struct Gemm { const bf16_t* A; const bf16_t* Bt; int K, lda, ldb, acol_shift, acol_bytes;
    __device__ __forceinline__ const char* abase(const Unit& u) const { return (const char*)A + (size_t)u.pm * 512 * lda + (size_t)((u.pn >> acol_shift) * acol_bytes); }
    __device__ __forceinline__ const char* bbase(const Unit& u) const { return (const char*)Bt + (size_t)u.pn * 512 * ldb; } };

struct StaticOrder {
    int nM, nN, nwg, G, c, WGM;
    __host__ __device__ void init(int M, int N, int G_, int c_, int wgm = 16) { nM = M / BM; nN = N / BM; nwg = nM * nN; G = G_; c = c_; WGM = wgm; }
    __host__ __device__ bool next(int i, Unit& u) const {
        const long L = (long)i * G + c; if (L >= nwg) return false;
        int wgid = (int)L; { const int q = nwg / NXCD, r = nwg % NXCD, xcd = wgid % NXCD, off = wgid / NXCD; wgid = (xcd < r ? xcd * (q + 1) : r * (q + 1) + (xcd - r) * q) + off; }
        const int nig = WGM * nN, gid = wgid / nig, fm = gid * WGM, gsz = (nM - fm) < WGM ? (nM - fm) : WGM;
        u.pm = fm + ((wgid % nig) % gsz); u.pn = (wgid % nig) / gsz; return true;
    }
    __device__ __forceinline__ void a_ready(const Unit&) const {}
    __device__ __forceinline__ void done(const Unit&) const {}
};

#ifndef PG_ZEROC
#define PG_ZEROC 1
#endif
template <class Epi, class Sched, bool ALIGN_EPI = false, bool SP2 = false>
__device__ __forceinline__ void gemm_phase(PG8_LAS unsigned char* lds, const int wid, const Gemm g, const Sched& S, const Epi& E) {
    unsigned z_ = 0u; asm volatile("" : "+v"(z_));
    const int lane = (int)__builtin_amdgcn_mbcnt_hi(~0u, __builtin_amdgcn_mbcnt_lo(~0u, z_)), tid = wid * 64 + lane, wr = wid >> 2, wc = wid & 3, fr = lane & 15, fq = lane >> 4;
#if defined(PROBE_K2) && PROBE_K2
    const int K = g.K, ntr = K / BK, nt = 2 * ntr;
#define PG8_KT(t_) ((t_) % ntr)
#else
    const int K = g.K, nt = K / BK;
#define PG8_KT(t_) (t_)
#endif
    unsigned voffA[2], voffB[2];
#pragma unroll
    for (int i = 0; i < 2; ++i) { int R, C; stage_rc(tid * 16 + i * 8192, R, C); const int Rb = Epi::PERM ? ((R & ~31) + perm32(R & 31)) : R;
        voffA[i] = (unsigned)(((R >> 4) * (g.lda >> 5) + (C >> 5)) * 1024 + (R & 15) * 64 + (C & 31) * 2); voffB[i] = (unsigned)(((Rb >> 4) * (g.ldb >> 5) + (C >> 5)) * 1024 + (Rb & 15) * 64 + (C & 31) * 2); }
    const size_t kstep = 2048, kstepB = 2048;
    const size_t hstepA = (size_t)HALF * g.lda * 2, hstepB = (size_t)HALF * g.ldb * 2;

    const unsigned ldsw = (unsigned)wid * 1024u;
    const int aoff = lds_byte(wr * 64 + fr, fq * 8), boff = lds_byte(wc * 32 + fr, fq * 8);
#define PG8_SA(b, h) (((b) * 2 + (h)) * HTB)
#define PG8_SB(b, h) ((4 + (b) * 2 + (h)) * HTB)
#define PG8_STAGE(bufoff, gbase, voff) do { _Pragma("unroll") for (int _i = 0; _i < 2; ++_i) \
        __builtin_amdgcn_global_load_lds((const unsigned*)((const char*)(gbase) + (voff)[_i]), (PG8_LAS unsigned*)(lds + (bufoff) + ldsw + _i * 8192), 16, 0, 0); } while (0)
#define PG8_LDA(dst, b, h) do { _Pragma("unroll") for (int m = 0; m < 4; ++m) _Pragma("unroll") for (int k = 0; k < 2; ++k) dst[m][k] = *(const PG8_LAS bf16x8*)(lds + PG8_SA(b, h) + aoff + m * 2048 + k * 1024); } while (0)
#define PG8_LDB(dst, b, h) do { _Pragma("unroll") for (int n = 0; n < 2; ++n) _Pragma("unroll") for (int k = 0; k < 2; ++k) dst[n][k] = *(const PG8_LAS bf16x8*)(lds + PG8_SB(b, h) + boff + n * 2048 + k * 1024); } while (0)
#define PG8_MMA(ai, bj, At, Bt) do { PG8_PRIO(1); _Pragma("unroll") for (int m = 0; m < 4; ++m) _Pragma("unroll") for (int n = 0; n < 2; ++n) _Pragma("unroll") for (int k = 0; k < 2; ++k) \
        { acc[ai][bj][m][n] = __builtin_amdgcn_mfma_f32_16x16x32_bf16(Bt[n][k], At[m][k], acc[ai][bj][m][n], 0, 0, 0); PG8_MMA_AGAIN(ai, bj, m, n, k, At, Bt) } PG8_PRIO(0); } while (0)
#define PG8_MMAZ(ai, bj, At, Bt) do { PG8_PRIO(1); _Pragma("unroll") for (int m = 0; m < 4; ++m) _Pragma("unroll") for (int n = 0; n < 2; ++n) \
        { asm("v_mfma_f32_16x16x32_bf16 %0, %1, %2, 0" : "=&v"(acc[ai][bj][m][n]) : "v"(Bt[n][0]), "v"(At[m][0])); \
          acc[ai][bj][m][n] = __builtin_amdgcn_mfma_f32_16x16x32_bf16(Bt[n][1], At[m][1], acc[ai][bj][m][n], 0, 0, 0); } PG8_PRIO(0); } while (0)
#if defined(PROBE_MMA2) && PROBE_MMA2
#define PG8_MMA_AGAIN(ai, bj, m, n, k, At, Bt) acc[ai][bj][m][n] = __builtin_amdgcn_mfma_f32_16x16x32_bf16(Bt[n][k], At[m][k], acc[ai][bj][m][n], 0, 0, 0);
#else
#define PG8_MMA_AGAIN(ai, bj, m, n, k, At, Bt)
#endif
#if defined(PG_STATIC_PRIO) && PG_STATIC_PRIO
#define PG8_PRIO(x)
#else
#define PG8_PRIO(x) __builtin_amdgcn_s_setprio(x)
#endif
#define PG8_WAIT_V(n) asm volatile("s_waitcnt vmcnt(" #n ")" ::: "memory")
#define PG8_WAIT_L(n) asm volatile("s_waitcnt lgkmcnt(" #n ")" ::: "memory")
#define PG8_BAR __builtin_amdgcn_s_barrier()
#define PG8_SCHED __builtin_amdgcn_sched_barrier(0)
#define PG8_SP2SEQ(PG8_MA_, PG8_MB_) \
            PG8_LDB(B0, 0, 0); PG8_LDB(B1, 0, 1); PG8_SCHED; PG8_LDA(At, 0, 0); PG8_STAGE(PG8_SA(1, 1), a1 + hstepA, voffA); \
            PG8_WAIT_V(8); PG8_WAIT_L(0); PG8_BAR; PG8_MA_(0, 0, At, B0); PG8_MA_(0, 1, At, B1); PG8_BAR; PG8_SCHED; \
            PG8_LDA(At, 0, 1); PG8_STAGE(PG8_SB(0, 0), b2, voffB); PG8_STAGE(PG8_SB(0, 1), b2 + hstepB, voffB); PG8_STAGE(PG8_SA(0, 0), a2, voffA); \
            PG8_WAIT_V(8); PG8_WAIT_L(0); PG8_BAR; PG8_MA_(1, 0, At, B0); PG8_MA_(1, 1, At, B1); PG8_BAR; PG8_SCHED; \
            PG8_LDB(B0, 1, 0); PG8_LDB(B1, 1, 1); PG8_SCHED; PG8_LDA(At, 1, 0); PG8_STAGE(PG8_SA(0, 1), a2 + hstepA, voffA); \
            PG8_WAIT_V(8); PG8_WAIT_L(0); PG8_BAR; PG8_MB_(0, 0, At, B0); PG8_MB_(0, 1, At, B1); PG8_BAR; PG8_SCHED; \
            PG8_LDA(At, 1, 1); PG8_STAGE(PG8_SB(1, 0), b3, voffB); PG8_STAGE(PG8_SB(1, 1), b3 + hstepB, voffB); PG8_STAGE(PG8_SA(1, 0), a3, voffA); \
            PG8_WAIT_V(8); PG8_WAIT_L(0); PG8_BAR; PG8_MB_(1, 0, At, B0); PG8_MB_(1, 1, At, B1); PG8_BAR; PG8_SCHED;
    Unit cur, nxt; int ui = 0;
    if (!S.next(0, cur)) return;
#if defined(PG_STATIC_PRIO) && PG_STATIC_PRIO
    if (wr == (PG_STATIC_PRIO - 1)) __builtin_amdgcn_s_setprio(1);
#endif
    f32x4 acc[2][2][4][2];
    if constexpr (!SP2 || !PG_ZEROC) {
#pragma unroll
    for (int a = 0; a < 2; ++a)
#pragma unroll
        for (int b = 0; b < 2; ++b)
#pragma unroll
            for (int m = 0; m < 4; ++m)
#pragma unroll
                for (int n = 0; n < 2; ++n) acc[a][b][m][n] = (f32x4){0.f, 0.f, 0.f, 0.f};
    }
    bf16x8 At[4][2], B0[2][2], B1[2][2];
    const char* cA = g.abase(cur); const char* cB = g.bbase(cur);
    S.a_ready(cur);
    E.first_unit(cur, wid);
    if constexpr (SP2) {
        PG8_STAGE(PG8_SB(0, 0), cB, voffB); PG8_STAGE(PG8_SB(0, 1), cB + hstepB, voffB); PG8_STAGE(PG8_SA(0, 0), cA, voffA); PG8_STAGE(PG8_SA(0, 1), cA + hstepA, voffA);
        if (wr == 1) PG8_BAR;
        PG8_WAIT_V(2); PG8_BAR;
        PG8_STAGE(PG8_SB(1, 0), cB + kstepB, voffB); PG8_STAGE(PG8_SA(1, 0), cA + kstep, voffA); PG8_STAGE(PG8_SB(1, 1), cB + hstepB + kstepB, voffB);
        PG8_WAIT_V(6); PG8_BAR;
    } else {
        PG8_STAGE(PG8_SB(0, 0), cB, voffB); PG8_STAGE(PG8_SA(0, 0), cA, voffA); PG8_STAGE(PG8_SB(0, 1), cB + hstepB, voffB); PG8_STAGE(PG8_SA(0, 1), cA + hstepA, voffA);
        if (wr == 1) PG8_BAR;
        PG8_WAIT_V(4); PG8_BAR;
        PG8_STAGE(PG8_SB(1, 0), cB + kstepB, voffB); PG8_STAGE(PG8_SA(1, 0), cA + kstep, voffA); PG8_STAGE(PG8_SB(1, 1), cB + hstepB + kstepB, voffB);
        PG8_WAIT_V(6); PG8_BAR;
    }
    for (;;) {
        const bool has_next = S.next(ui + 1, nxt);
        const char* nA = has_next ? g.abase(nxt) : cA; const char* nB = has_next ? g.bbase(nxt) : cB;
#define PG8_PRE(t) \
            const bool last = ((t) == nt - 2); \
            const char* a1 = cA + (size_t)PG8_KT((t) + 1) * kstep;                                             \
            const char* a2 = last ? nA : cA + (size_t)PG8_KT((t) + 2) * kstep; const char* b2 = last ? nB : cB + (size_t)PG8_KT((t) + 2) * kstepB;     \
            const char* a3 = a2 + kstep; const char* b3 = b2 + kstepB;                                \
            if (last && has_next) S.a_ready(nxt);
        if constexpr (SP2 && PG_ZEROC) { PG8_PRE(0) PG8_SP2SEQ(PG8_MMAZ, PG8_MMA) }
        for (int t = (SP2 && PG_ZEROC) ? 2 : 0; t < nt; t += 2) {
            PG8_PRE(t)
            if constexpr (SP2) {
                PG8_SP2SEQ(PG8_MMA, PG8_MMA)
            } else {
            PG8_LDB(B0, 0, 0); PG8_SCHED; PG8_LDA(At, 0, 0); PG8_STAGE(PG8_SA(1, 1), a1 + hstepA, voffA);
            PG8_WAIT_L(8); PG8_BAR; PG8_WAIT_L(0); PG8_MMA(0, 0, At, B0); PG8_BAR; PG8_SCHED;
            PG8_LDB(B1, 0, 1); PG8_STAGE(PG8_SB(0, 0), b2, voffB);
            PG8_BAR; PG8_WAIT_L(0); PG8_MMA(0, 1, At, B1); PG8_BAR;
            PG8_LDA(At, 0, 1); PG8_STAGE(PG8_SA(0, 0), a2, voffA);
            PG8_BAR; PG8_WAIT_L(0); PG8_MMA(1, 0, At, B0); PG8_BAR; PG8_SCHED;
            PG8_STAGE(PG8_SB(0, 1), b2 + hstepB, voffB);
            PG8_WAIT_V(6); PG8_BAR; PG8_MMA(1, 1, At, B1); PG8_BAR;
            PG8_LDB(B0, 1, 0); PG8_SCHED; PG8_LDA(At, 1, 0); PG8_STAGE(PG8_SA(0, 1), a2 + hstepA, voffA);
            PG8_WAIT_L(8); PG8_BAR; PG8_WAIT_L(0); PG8_MMA(0, 0, At, B0); PG8_BAR; PG8_SCHED;
            PG8_LDB(B1, 1, 1); PG8_STAGE(PG8_SB(1, 0), b3, voffB);
            PG8_BAR; PG8_WAIT_L(0); PG8_MMA(0, 1, At, B1); PG8_BAR;
            PG8_LDA(At, 1, 1); PG8_STAGE(PG8_SA(1, 0), a3, voffA);
            PG8_BAR; PG8_WAIT_L(0); PG8_MMA(1, 0, At, B0); PG8_BAR; PG8_SCHED;
            PG8_STAGE(PG8_SB(1, 1), b3 + hstepB, voffB);
            PG8_WAIT_V(6); PG8_BAR; PG8_MMA(1, 1, At, B1); PG8_BAR;
            }
        }
        if constexpr (ALIGN_EPI) { if (wr == 0) PG8_BAR; }
        if constexpr (!Epi::AFTER_DRAIN) { E(acc, cur, nxt, has_next, ui, wr, wc, fr, fq);
#if defined(PROBE_EPI2) && PROBE_EPI2
            if constexpr (Epi::IDEMP) E(acc, cur, nxt, has_next, ui, wr, wc, fr, fq);
#endif
            S.done(cur); }
        if (!has_next) break;
        if constexpr (!SP2 || !PG_ZEROC) {
#pragma unroll
        for (int a = 0; a < 2; ++a)
#pragma unroll
            for (int b = 0; b < 2; ++b)
#pragma unroll
                for (int m = 0; m < 4; ++m)
#pragma unroll
                    for (int n = 0; n < 2; ++n) acc[a][b][m][n] = (f32x4){0.f, 0.f, 0.f, 0.f};
        }
        cur = nxt; cA = nA; cB = nB; ++ui;
        if constexpr (ALIGN_EPI) { if (wr == 1) PG8_BAR; }
    }
#if defined(PG_STATIC_PRIO) && PG_STATIC_PRIO
    __builtin_amdgcn_s_setprio(0);
#endif
    PG8_WAIT_V(0);
    if constexpr (!ALIGN_EPI) { if (wr == 0) PG8_BAR; }
    PG8_BAR;
    if constexpr (Epi::AFTER_DRAIN) { E.fused(acc, cur, wr, wc, fr, fq, lds, wid, lane); S.done(cur); }
#undef PG8_KT
#undef PG8_SA
#undef PG8_SB
#undef PG8_STAGE
#undef PG8_LDA
#undef PG8_LDB
#undef PG8_MMA
#undef PG8_MMAZ
#undef PG8_PRE
#undef PG8_SP2SEQ
#undef PG8_PRIO
#undef PG8_WAIT_V
#undef PG8_WAIT_L
#undef PG8_BAR
#undef PG8_SCHED
}
}

constexpr int D = 1024, BATCH = 4, SEQ = 8192, DECB = 128, DECT = 4;
constexpr int MP = BATCH * SEQ, MS = DECB * DECT, M = MP + MS;
constexpr int NH = 16, NKV = 4, HD = 64, DFF = 2816, NQKV = 1536;
constexpr float EPS = 1e-6f, LOG2E = 1.4426950408889634f, C2 = 0.125f * LOG2E;
constexpr size_t OFF_Y = 0, OFF_NK_P = 34078720, OFF_NV_P = 34209792, OFF_NK_S = 34340864, OFF_NV_S = 38535168,
                 OFF_NC_P = 42729472, OFF_NH_P = 42741760, OFF_NC_S = 42745856, OFF_NH_S = 43139072;
constexpr size_t MiB = 1u << 20;
constexpr size_t WS_CTL = 0, CTL_ZERO_BYTES = 32768;
constexpr size_t WS_WQKV = 2 * MiB, WS_WO = 5 * MiB, WS_WFI0 = 7 * MiB, WS_WFO0 = 18 * MiB, WS_WRI = 24 * MiB, WS_WG = 28 * MiB, WS_WRO = 29 * MiB, WS_WFI1 = 31 * MiB, WS_WFO1 = 42 * MiB;
constexpr size_t WS_SSS = 48 * MiB + (size_t)33280 * 32;
constexpr size_t WS_SS = 48 * MiB;
constexpr size_t WS_SLA = 51 * MiB, WS_HT = 52 * MiB;
constexpr size_t WS_XB = 56 * MiB;
constexpr size_t WS_R = 128 * MiB;
constexpr size_t WS_Q = WS_R, WS_K = WS_R + 65 * MiB, WS_V = WS_R + 82 * MiB, WS_O = WS_R + 99 * MiB;
constexpr size_t WS_H = WS_R;
constexpr size_t WS_GG = WS_R, WS_XBC = WS_R + 65 * MiB, WS_XC = WS_R + 130 * MiB, WS_LA = WS_R + 195 * MiB, WS_BB = WS_R + 260 * MiB;
constexpr size_t WS_SUBS = WS_R + 326 * MiB, WS_SUBH = WS_R + 330 * MiB;
constexpr size_t WS_END = WS_R + 334 * MiB;
static_assert(WS_END <= 512 * MiB, "ws map");
constexpr int CW_TMO = 0, CW_BAR = 4096;
constexpr int RING_BYTES = 131072, LDSCTL_OFF = RING_BYTES, MISC_OFF = LDSCTL_OFF + 320, LDS_BYTES = 147456;
constexpr int NWAVES = 8;
#ifndef WGM_FI
#define WGM_FI 8
#endif
#ifndef WGM_FO
#define WGM_FO 8
#endif
#ifndef WGM_OT
#define WGM_OT 16
#endif
#define WGM_OF(N_, K_) ((N_) == 2 * DFF ? WGM_FI : ((K_) == DFF ? WGM_FO : WGM_OT))

#define GAS __attribute__((address_space(1)))
#define LAS __attribute__((address_space(3)))
typedef unsigned short bf16;
typedef unsigned v4u __attribute__((ext_vector_type(4)));
typedef unsigned v2u __attribute__((ext_vector_type(2)));
typedef float f32x4 __attribute__((ext_vector_type(4)));
typedef float f32x2 __attribute__((ext_vector_type(2)));
typedef float f32x16 __attribute__((ext_vector_type(16)));
typedef short bf16x8 __attribute__((ext_vector_type(8)));
typedef short s16x4 __attribute__((ext_vector_type(4)));
typedef _Float16 h16x2 __attribute__((ext_vector_type(2)));
typedef _Float16 h16x8 __attribute__((ext_vector_type(8)));
typedef GAS unsigned gu32;
#define RLX_AGENT __ATOMIC_RELAXED, __HIP_MEMORY_SCOPE_AGENT
#define LDS_WAIT() asm volatile("s_waitcnt lgkmcnt(0)" ::: "memory")
#define VM_WAIT() asm volatile("s_waitcnt vmcnt(0)" ::: "memory")
__device__ __forceinline__ unsigned f2bf(float f) { unsigned u = __builtin_bit_cast(unsigned, f); return (u + 0x7fffu + ((u >> 16) & 1u)) >> 16; }
typedef float f32x2_t_ __attribute__((ext_vector_type(2))); typedef __bf16 bf16x2_t_ __attribute__((ext_vector_type(2)));
__device__ __forceinline__ unsigned pk2(float lo, float hi) { f32x2_t_ v = {lo, hi}; bf16x2_t_ b = __builtin_convertvector(v, bf16x2_t_); return __builtin_bit_cast(unsigned, b); }
__device__ __forceinline__ v4u pack8(f32x4 a, f32x4 b) { v4u w; w.x = pk2(a[0], a[1]); w.y = pk2(a[2], a[3]); w.z = pk2(b[0], b[1]); w.w = pk2(b[2], b[3]); return w; }
__device__ __forceinline__ float bf2f(unsigned short b) { return __builtin_bit_cast(float, (unsigned)b << 16); }
__device__ __forceinline__ float bflo(unsigned w) { return __builtin_bit_cast(float, w << 16); }
__device__ __forceinline__ float bfhi(unsigned w) { return __builtin_bit_cast(float, w & 0xffff0000u); }
__device__ __forceinline__ float ex2(float x) { return __builtin_amdgcn_exp2f(x); }
__device__ __forceinline__ float rcpf_(float x) { return __builtin_amdgcn_rcpf(x); }
__device__ __forceinline__ float wave_sum(float v) {
#pragma unroll
    for (int o = 1; o < 64; o <<= 1) v += __shfl_xor(v, o);
    return v;
}
__device__ __forceinline__ float wave_max(float v) {
#pragma unroll
    for (int o = 1; o < 64; o <<= 1) v = fmaxf(v, __shfl_xor(v, o));
    return v;
}

__device__ __forceinline__ unsigned blk_off(int row, int col, int kdim) { return ((unsigned)(row >> 4) * (unsigned)(kdim >> 5) + (unsigned)(col >> 5)) * 512u + (unsigned)((row & 15) * 32 + (col & 31)); }
__device__ __forceinline__ int xb_lane_id() { unsigned z = 0u; asm volatile("" : "+v"(z)); return (int)__builtin_amdgcn_mbcnt_hi(~0u, __builtin_amdgcn_mbcnt_lo(~0u, z)); }
#define XB_T0(b) ((b).wave == 0 && xb_lane_id() == 0)
#define XB_TMO      128
#define XB_XCNT(j)  (256  + 64 * (j))
#define XB_XSUB(j)  (1280 + 64 * (j))
#define XB_XGEN(j)  (2304 + 64 * (j))
#define XB_TOP      3328
#define XB_TOPGEN   3392
#define XCD_BAR_WORDS 3456
#define XB_SPIN_CAP (1u << 18)

__device__ __forceinline__ unsigned xb_ld(unsigned* p)              { return __hip_atomic_load(p, __ATOMIC_RELAXED, __HIP_MEMORY_SCOPE_AGENT); }
__device__ __forceinline__ unsigned xb_add(unsigned* p, unsigned v) { return __hip_atomic_fetch_add(p, v, __ATOMIC_RELAXED, __HIP_MEMORY_SCOPE_AGENT); }
__device__ __forceinline__ unsigned xb_xcc_id() { return (unsigned)__builtin_amdgcn_s_getreg((3 << 11) | 20) & 0xFu; }
#define XB_SPIN(cond, bar) do { unsigned _sp = 0; while (cond) { __builtin_amdgcn_s_sleep(1); \
    if ((++_sp & 255u) == 0u) { if (xb_ld(&(bar)[XB_TMO])) break; if (_sp > XB_SPIN_CAP) { atomicAdd(&(bar)[XB_TMO], 1u); break; } } } } while (0)

struct XcdBarrier {
    unsigned* bar; unsigned x; unsigned G; int wave;
    volatile LAS unsigned* st;
};

__device__ __forceinline__ XcdBarrier xcd_barrier_post(unsigned* bar, volatile LAS unsigned* st, int wave, unsigned G) {
    XcdBarrier b; b.bar = bar; b.x = xb_xcc_id(); b.st = st; b.G = G; b.wave = wave;
    if (XB_T0(b)) (void)xb_add(&bar[XB_XCNT(b.x)], 1u);
    return b;
}
__device__ __forceinline__ void xcd_barrier_complete(unsigned* bar, unsigned x, const unsigned G, unsigned& nloc, unsigned& nx) {
    unsigned sum, cnt, mine, sp = 0u;
    for (;;) {
        sum = 0u; cnt = 0u; mine = 0u;
#pragma unroll
        for (unsigned j = 0; j < 16; ++j) { const unsigned c = xb_ld(&bar[XB_XCNT(j)]); sum += c; cnt += (c > 0u) ? 1u : 0u; mine = (j == x) ? c : mine; }
        if (sum == G) break;
        __builtin_amdgcn_s_sleep(1);
        if ((++sp & 255u) == 0u) { if (xb_ld(&bar[XB_TMO])) break; if (sp > XB_SPIN_CAP) { atomicAdd(&bar[XB_TMO], 1u); break; } }
    }
    nloc = mine > 0u ? mine : 1u; nx = cnt > 0u ? cnt : 1u;
}

__device__ __forceinline__ void xcd_barrier(const XcdBarrier& b) {
    asm volatile("s_waitcnt vmcnt(0)" ::: "memory");
    __syncthreads();
    if (XB_T0(b)) {
        unsigned* bar = b.bar;
        __builtin_amdgcn_s_waitcnt(0);
        unsigned nloc = b.st[0], nx = b.st[1];
        if (nloc == 0u) { xcd_barrier_complete(bar, b.x, b.G, nloc, nx); b.st[0] = nloc; b.st[1] = nx; }
        const unsigned old = xb_add(&bar[XB_XSUB(b.x)], 1u);
        const unsigned gen = old / nloc;
        if (old + 1u == (gen + 1u) * nloc) {
            __builtin_amdgcn_fence(__ATOMIC_RELEASE, "agent");
            asm volatile("s_waitcnt vmcnt(0)" ::: "memory");
            const unsigned og = xb_add(&bar[XB_TOP], 1u);
            const unsigned tg = og / nx;
            if (og + 1u == (tg + 1u) * nx) xb_add(&bar[XB_TOPGEN], 1u);
            else XB_SPIN(xb_ld(&bar[XB_TOPGEN]) == tg, bar);
            __builtin_amdgcn_fence(__ATOMIC_ACQUIRE, "agent");
            xb_add(&bar[XB_XGEN(b.x)], 1u);
            asm volatile("s_waitcnt vmcnt(0)" ::: "memory");
        } else {
            XB_SPIN(xb_ld(&bar[XB_XGEN(b.x)]) == gen, bar);
            __builtin_amdgcn_fence(__ATOMIC_ACQUIRE, "agent");
            asm volatile("s_waitcnt vmcnt(0)" ::: "memory");
        }
    }
    __syncthreads();
}

typedef __attribute__((address_space(4))) const unsigned char* kptr_t;
template <class T> __device__ __forceinline__ T karg(int byte_off) { return *(const __attribute__((address_space(4))) T*)((kptr_t)__builtin_amdgcn_kernarg_segment_ptr() + byte_off); }
#define KIN(k) karg<const float*>(8 * (k))
#define KOUT() karg<float*>(192)
#define KWS() karg<unsigned char*>(200)
__device__ __forceinline__ int lane_id_opaque() { unsigned z = 0u; asm volatile("" : "+v"(z)); return (int)__builtin_amdgcn_mbcnt_hi(~0u, __builtin_amdgcn_mbcnt_lo(~0u, z)); }
struct Frame {
    LAS unsigned char* lds;
    volatile LAS unsigned* MISC;
    int wave, vcu, G, dry;
};

__device__ __forceinline__ int rowmap(int mode, int moff, int n) {
    if (mode == 0) return n + moff;
    if (mode == 1) return n < DFF ? 256 * (n >> 7) + (n & 127) : 256 * ((n - DFF) >> 7) + 128 + ((n - DFF) & 127);
    return moff + 256 * (n >> 7) + (n & 127);
}
__device__ __forceinline__ void tr_item(const float* W, int ldw, int N, const float* gain, bf16* WT, int ldt, int mode, int moff, LAS float* scr, int item, int lane) {
    const int nblk = N / 32, kb = item / nblk, nb = item % nblk, k0 = 64 * kb, n0 = 32 * nb;
    f32x4 v[8]; float gn[8];
#pragma unroll
    for (int i = 0; i < 8; ++i) { const int kk = 8 * i + (lane >> 3); v[i] = *(const f32x4*)(W + (size_t)(k0 + kk) * ldw + n0 + 4 * (lane & 7)); gn[i] = gain ? gain[k0 + kk] : 1.0f; }
#pragma unroll
    for (int i = 0; i < 8; ++i) { const int kk = 8 * i + (lane >> 3); LAS float* d = scr + kk * 33 + 4 * (lane & 7); d[0] = v[i].x * gn[i]; d[1] = v[i].y * gn[i]; d[2] = v[i].z * gn[i]; d[3] = v[i].w * gn[i]; }
    LDS_WAIT(); asm volatile("" ::: "memory");
    const int c = lane & 7;
#pragma unroll
    for (int j = 0; j < 4; ++j) { const int n = (lane >> 3) + 8 * j; const LAS float* s = scr + (8 * c) * 33 + n;
        v4u o; o.x = pk2(s[0 * 33], s[1 * 33]); o.y = pk2(s[2 * 33], s[3 * 33]); o.z = pk2(s[4 * 33], s[5 * 33]); o.w = pk2(s[6 * 33], s[7 * 33]);
        const int wr_ = rowmap(mode, moff, n0 + n), wk_ = k0 + 8 * c;
        *(GAS v4u*)(WT + ((size_t)(wr_ >> 4) * (ldt >> 5) + (wk_ >> 5)) * 512 + (wr_ & 15) * 32 + (wk_ & 31)) = o; }
    LDS_WAIT(); asm volatile("" ::: "memory");
}
__device__ __forceinline__ void p0_prologue(Frame& F) {
    LAS float* scr = (LAS float*)(F.lds + F.wave * 16384);
    const int lane = lane_id_opaque();
    const int gw = F.vcu * NWAVES + F.wave, NGW = F.G * NWAVES;
    constexpr int I_QKV = 16 * 48, I_O = 16 * 32, I_FI = 16 * 176, I_FO = 44 * 32, I_RI = 16 * 64, I_G = 4 * 8, I_RO = 16 * 32;
    constexpr int NITEMS = I_QKV + I_O + 2 * I_FI + 2 * I_FO + I_RI + 8 * I_G + I_RO;
    unsigned char* ws = KWS();
    for (int it = gw; it < NITEMS; it += NGW) {
        int r = it;
        if (r < I_QKV) { tr_item(KIN(7), NQKV, NQKV, KIN(6), (bf16*)(ws + WS_WQKV), D, 0, 0, scr, r, lane); continue; } r -= I_QKV;
        if (r < I_O) { tr_item(KIN(8), D, D, nullptr, (bf16*)(ws + WS_WO), D, 0, 0, scr, r, lane); continue; } r -= I_O;
        if (r < I_FI) { tr_item(KIN(21), 2 * DFF, 2 * DFF, KIN(20), (bf16*)(ws + WS_WFI0), D, 1, 0, scr, r, lane); continue; } r -= I_FI;
        if (r < I_FI) { tr_item(KIN(21) + (size_t)D * 2 * DFF, 2 * DFF, 2 * DFF, KIN(20) + D, (bf16*)(ws + WS_WFI1), D, 1, 0, scr, r, lane); continue; } r -= I_FI;
        if (r < I_FO) { tr_item(KIN(22), D, D, nullptr, (bf16*)(ws + WS_WFO0), DFF, 0, 0, scr, r, lane); continue; } r -= I_FO;
        if (r < I_FO) { tr_item(KIN(22) + (size_t)DFF * D, D, D, nullptr, (bf16*)(ws + WS_WFO1), DFF, 0, 0, scr, r, lane); continue; } r -= I_FO;
        if (r < I_RI) { tr_item(KIN(11), 2048, 2048, KIN(10), (bf16*)(ws + WS_WRI), D, 0, 0, scr, r, lane); continue; } r -= I_RI;
        if (r < 8 * I_G) { const int q = r / I_G, blk = q >> 1, ig = q & 1;
            tr_item((ig ? KIN(16) : KIN(14)) + (size_t)blk * 65536, 256, 256, nullptr, (bf16*)(ws + WS_WG), 256, 2, 512 * blk + 128 * ig, scr, r % I_G, lane); continue; } r -= 8 * I_G;
        tr_item(KIN(19), D, D, nullptr, (bf16*)(ws + WS_WRO), D, 0, 0, scr, r, lane);
    }
    bf16* XB = (bf16*)(ws + WS_XB); float* SS = (float*)(ws + WS_SS);
    for (int m0 = 2 * gw; m0 < M; m0 += 2 * NGW) {
        const int m1 = m0 + 1;
        const float* xrow0 = m0 < MP ? KIN(0) + (size_t)m0 * D : KIN(1) + (size_t)(m0 - MP) * D;
        const float* xrow1 = m1 < MP ? KIN(0) + (size_t)m1 * D : KIN(1) + (size_t)(m1 - MP) * D;
        f32x4 v[2][2], w[2][2]; float s0 = 0.f, s1 = 0.f;
#pragma unroll
        for (int j = 0; j < 2; ++j) { const int col = 8 * lane + 512 * j;
            v[j][0] = *(const GAS f32x4*)(xrow0 + col); v[j][1] = *(const GAS f32x4*)(xrow0 + col + 4); w[j][0] = *(const GAS f32x4*)(xrow1 + col); w[j][1] = *(const GAS f32x4*)(xrow1 + col + 4); }
#pragma unroll
        for (int j = 0; j < 2; ++j)
#pragma unroll
            for (int n = 0; n < 2; ++n) { s0 += (v[j][n].x * v[j][n].x + v[j][n].y * v[j][n].y) + (v[j][n].z * v[j][n].z + v[j][n].w * v[j][n].w);
                s1 += (w[j][n].x * w[j][n].x + w[j][n].y * w[j][n].y) + (w[j][n].z * w[j][n].z + w[j][n].w * w[j][n].w); }
        s0 = wave_sum(s0); s1 = wave_sum(s1);
#pragma unroll
        for (int j = 0; j < 2; ++j) { const int col = 8 * lane + 512 * j;
            *(GAS v4u*)(XB + blk_off(m0, col, D)) = pack8(v[j][0], v[j][1]); *(GAS v4u*)(XB + blk_off(m1, col, D)) = pack8(w[j][0], w[j][1]); }
        if (m0 < MP) {
            if (lane < 2) *(GAS f32x4*)(SS + (size_t)m0 * 8 + 4 * lane) = (f32x4){lane == 0 ? s0 : 0.f, 0.f, 0.f, 0.f};
            else if (lane < 4) *(GAS f32x4*)(SS + (size_t)m1 * 8 + 4 * (lane - 2)) = (f32x4){lane == 2 ? s1 : 0.f, 0.f, 0.f, 0.f};
        } else if (lane < 8) {
            *(GAS f32x4*)((float*)(ws + WS_SSS) + (size_t)(m0 - MP) * 16 + 4 * lane) = (f32x4){lane == 0 ? s0 : (lane == 4 ? s1 : 0.f), 0.f, 0.f, 0.f}; }
    }
    {
        const int gt = gw * 64 + lane, NGT = NGW * 64; constexpr int PER_B = 31744 / 4;
        constexpr int TOT = 2 * DECB * PER_B;
        for (int i0 = gt; i0 < TOT; i0 += 4 * NGT) {
            f32x4 val[4]; float* dst[4];
#pragma unroll
            for (int q = 0; q < 4; ++q) { const int i = i0 + q * NGT; const int ic = i < TOT ? i : i0;
                const int which = ic / (DECB * PER_B), r = ic % (DECB * PER_B), b = r / PER_B, e = r % PER_B;
                const float* src = (which ? KIN(3) : KIN(2)) + (size_t)b * 32768 + 1024 + (size_t)e * 4;
                dst[q] = KOUT() + (which ? OFF_NV_S : OFF_NK_S) + (size_t)b * 32768 + (size_t)e * 4;
                val[q] = *(const GAS f32x4*)src; }
#pragma unroll
            for (int q = 0; q < 4; ++q) if (i0 + q * NGT < TOT) *(GAS f32x4*)dst[q] = val[q];
        }
    }
}

using pg8::Unit;
__device__ __forceinline__ float msq_of(f32x4 a, f32x4 b) { const f32x2 s = ((f32x2){a.x, a.y} + (f32x2){a.z, a.w}) + ((f32x2){b.x, b.y} + (f32x2){b.z, b.w}); return (s.x + s.y) * (1.0f / D) + EPS; }
__device__ __forceinline__ float rstd_of(f32x4 a, f32x4 b) { return __builtin_amdgcn_rsqf(msq_of(a, b)); }
#ifndef ST_BUF
#define ST_BUF 0
#endif
#if ST_BUF
typedef __amdgpu_buffer_rsrc_t rsrc_t;
__device__ __forceinline__ rsrc_t ws_rsrc(unsigned char* ws) { return __builtin_amdgcn_make_buffer_rsrc(ws, 0, 0x20000000, 0x00020000); }
__device__ __forceinline__ void st16_wt(rsrc_t r, size_t byte_off, v4u v) { __builtin_amdgcn_raw_buffer_store_b128(v, r, (int)byte_off, 0, 0); }
#else
typedef unsigned char* rsrc_t;
__device__ __forceinline__ rsrc_t ws_rsrc(unsigned char* ws) { return ws; }
__device__ __forceinline__ void st16_wt(rsrc_t r, size_t byte_off, v4u v) { *(v4u*)(r + byte_off) = v; }
#endif
struct NoPre {};
struct OpQKV { static constexpr bool CUSTOM = false, PAIRED = false, NEEDS_RSTD = true, HAS_SS = false, WANTS_MSQ = false; typedef NoPre Pre;
    rsrc_t R; const float* SS; float* out;
    __device__ __forceinline__ void init() { unsigned char* ws = KWS(); out = KOUT(); R = ws_rsrc(ws); SS = (const float*)(ws + WS_SS); }
    __device__ __forceinline__ void prep(int, int) {}
    __device__ __forceinline__ Pre preload(int, int, int) const { return Pre{}; }
    __device__ __forceinline__ float apply(int row, int pn, int c, float rs, f32x4 v0, f32x4 v1, const Pre&) const {
        v0 = v0 * rs; v1 = v1 * rs;
        if (pn < 4) { v0 = v0 * C2; v1 = v1 * C2; st16_wt(R, WS_Q + blk_off(row, pn * 256 + c, D) * 2, pack8(v0, v1)); }
        else { st16_wt(R, (pn == 4 ? WS_K : WS_V) + blk_off(row, c, 256) * 2, pack8(v0, v1));
            float* o = nullptr;
            if (row < MP) { const int t = row & (SEQ - 1); if (t >= SEQ - 128) o = out + (pn == 4 ? OFF_NK_P : OFF_NV_P) + (size_t)((row >> 13) * 128 + t - (SEQ - 128)) * 256 + c; }
            else { const int rr = row - MP; o = out + (pn == 4 ? OFF_NK_S : OFF_NV_S) + (size_t)((rr >> 2) * 128 + 124 + (rr & 3)) * 256 + c; }
            if (o) { *(f32x4*)o = v0; *(f32x4*)(o + 4) = v1; } }
        return 0.f; }
};
struct OpRes { static constexpr bool CUSTOM = false, PAIRED = false, NEEDS_RSTD = false, HAS_SS = true, WANTS_MSQ = false; struct Pre { v4u w; };
    bf16* XB; float* SS; rsrc_t R;
    __device__ __forceinline__ void init() { unsigned char* ws = KWS(); XB = (bf16*)(ws + WS_XB); SS = (float*)(ws + WS_SS); R = ws_rsrc(ws); }
    __device__ __forceinline__ void prep(int, int) {}
    __device__ __forceinline__ Pre preload(int row, int pn, int c) const { Pre p; p.w = *(const v4u*)(XB + blk_off(row, pn * 256 + c, D)); return p; }
    __device__ __forceinline__ float apply(int row, int pn, int c, float, f32x4 v0, f32x4 v1, const Pre& p) const {
        const v4u w = p.w;
        v0[0] += bflo(w.x); v0[1] += bfhi(w.x); v0[2] += bflo(w.y); v0[3] += bfhi(w.y); v1[0] += bflo(w.z); v1[1] += bfhi(w.z); v1[2] += bflo(w.w); v1[3] += bfhi(w.w);
        st16_wt(R, WS_XB + blk_off(row, pn * 256 + c, D) * 2, pack8(v0, v1));
        const f32x4 sq = v0 * v0 + v1 * v1; return (sq[0] + sq[1]) + (sq[2] + sq[3]); }
};
struct OpSwiglu { static constexpr bool CUSTOM = false, PAIRED = true, NEEDS_RSTD = true, HAS_SS = false, WANTS_MSQ = true; typedef NoPre Pre;
    rsrc_t R; const float* SS;
    __device__ __forceinline__ void init() { unsigned char* ws = KWS(); R = ws_rsrc(ws); SS = (const float*)(ws + WS_SS); }
    __device__ __forceinline__ void prep(int, int) {}
    __device__ __forceinline__ Pre preload(int, int, int) const { return Pre{}; }
    __device__ __forceinline__ void apply2(int row, int pn, int c, float msq, f32x4 g0, f32x4 g1, f32x4 u0, f32x4 u1, const Pre&) const {
        const float c1 = -LOG2E * __builtin_amdgcn_rsqf(msq);
        const f32x4 x0 = g0 * c1, x1 = g1 * c1;
        const f32x4 e0 = {ex2(x0[0]), ex2(x0[1]), ex2(x0[2]), ex2(x0[3])}, e1 = {ex2(x1[0]), ex2(x1[1]), ex2(x1[2]), ex2(x1[3])};
        const f32x4 d0 = e0 * msq + msq, d1 = e1 * msq + msq;
        const f32x4 q0 = {rcpf_(d0[0]), rcpf_(d0[1]), rcpf_(d0[2]), rcpf_(d0[3])}, q1 = {rcpf_(d1[0]), rcpf_(d1[1]), rcpf_(d1[2]), rcpf_(d1[3])};
        const f32x4 h0 = (g0 * u0) * q0, h1 = (g1 * u1) * q1;
        st16_wt(R, WS_H + blk_off(row, pn * 128 + c, DFF) * 2, pack8(h0, h1));
#if defined(PROBE_ST2) && PROBE_ST2
        st16_wt(R, WS_LA + blk_off(row & 16383, pn * 128 + c, DFF) * 2, pack8(h1, h0));
#endif
    }
};
template <int K> __device__ __forceinline__ float dpp_hist(float cur, float prev) {
    const int o = __builtin_amdgcn_update_dpp(0, __builtin_bit_cast(int, prev), 0x120 + K, 0xf, 0xf, true);
    const int r = __builtin_amdgcn_update_dpp(o, __builtin_bit_cast(int, cur), 0x110 + K, 0xf, 0xf, false);
    return __builtin_bit_cast(float, r); }
__device__ __forceinline__ f32x4 gelu_tanh4(f32x4 g) { constexpr float K0 = -2.0f * LOG2E * 0.7978845608028654f, K1 = K0 * 0.044715f;
    const f32x4 t = (g * g) * K1 + K0, z = t * g; const f32x4 d = (f32x4){ex2(z[0]), ex2(z[1]), ex2(z[2]), ex2(z[3])} + 1.0f;
    return g * (f32x4){rcpf_(d[0]), rcpf_(d[1]), rcpf_(d[2]), rcpf_(d[3])}; }
__device__ __forceinline__ float gelu_tanh_f(float g) { const float z = 0.7978845608028654f * (g + 0.044715f * g * g * g); return g * rcpf_(1.0f + ex2(-2.0f * LOG2E * z)); }
struct OpRecIn { static constexpr bool CUSTOM = true, PAIRED = false, NEEDS_RSTD = true, HAS_SS = false, WANTS_MSQ = false; typedef NoPre Pre;
    rsrc_t R; unsigned char* W; const float* SS; float* out;
    __device__ __forceinline__ void init() { unsigned char* ws = KWS(); out = KOUT(); R = ws_rsrc(ws); W = ws; SS = (const float*)(ws + WS_SS); }
    __device__ __forceinline__ void prep(int, int) {}
    __device__ __forceinline__ Pre preload(int, int, int) const { return Pre{}; }
    __device__ __forceinline__ float apply(int, int, int, float, f32x4, f32x4, const Pre&) const { return 0.f; }
    __device__ __forceinline__ void custom(const f32x4 (&acc)[2][2][4][2], const Unit& u, int wr, int wc, int fr, int fq, const float (&rsv)[2][4]) const {
        const int pn = u.pn, c0 = wc * 32 + 8 * fq;
        if (pn < 4) {
#pragma unroll
            for (int ai = 0; ai < 2; ++ai)
#pragma unroll
                for (int m = 0; m < 4; ++m) { const int row = u.pm * 256 + ai * 128 + wr * 64 + m * 16 + fr; const float rs = rsv[ai][m];
#pragma unroll
                    for (int bj = 0; bj < 2; ++bj) { f32x4 v0 = acc[ai][bj][m][0] * rs, v1 = acc[ai][bj][m][1] * rs;
                        v0 = gelu_tanh4(v0); v1 = gelu_tanh4(v1);
                        st16_wt(R, WS_GG + blk_off(row, pn * 256 + bj * 128 + c0, D) * 2, pack8(v0, v1)); } }
        } else {
            const float* cwp = KIN(12); const float* cbp = KIN(13);
#pragma unroll
            for (int bj = 0; bj < 2; ++bj)
#pragma unroll
              for (int n = 0; n < 2; ++n) { const int col = (pn - 4) * 256 + bj * 128 + c0 + 4 * n;
                asm volatile("" ::: "memory");
                const f32x4 cb = *(const f32x4*)(cbp + col), w0 = *(const f32x4*)(cwp + col), w1 = *(const f32x4*)(cwp + D + col), w2 = *(const f32x4*)(cwp + 2 * D + col), w3 = *(const f32x4*)(cwp + 3 * D + col);
#pragma unroll
                for (int ai = 0; ai < 2; ++ai) { f32x4 prev = (f32x4){0.f, 0.f, 0.f, 0.f};
#pragma unroll
                    for (int m = 0; m < 4; ++m) { const int row = u.pm * 256 + ai * 128 + wr * 64 + m * 16 + fr;
                        const f32x4 cur = acc[ai][bj][m][n] * rsv[ai][m]; f32x4 h1, h2, h3;
#pragma unroll
                        for (int e = 0; e < 4; ++e) { h1[e] = dpp_hist<1>(cur[e], prev[e]); h2[e] = dpp_hist<2>(cur[e], prev[e]); h3[e] = dpp_hist<3>(cur[e], prev[e]); }
                        const f32x4 xc = cb + w3 * cur + w2 * h1 + w1 * h2 + w0 * h3; prev = cur;
                        if (m > 0 || fr >= 3) { v2u w; w.x = pk2(xc[0], xc[1]); w.y = pk2(xc[2], xc[3]); *(v2u*)(W + WS_XC + blk_off(row, col, D) * 2) = w; }
                        if ((m == 0 && fr < 3) || (m == 3 && fr >= 13)) { v2u w; w.x = pk2(cur[0], cur[1]); w.y = pk2(cur[2], cur[3]); *(v2u*)(W + WS_XBC + ((size_t)row * D + col) * 2) = w; }
                        const int t = row & (SEQ - 1);
                        if (t >= SEQ - 3) *(f32x4*)(out + OFF_NC_P + (size_t)((row >> 13) * 3 + t - (SEQ - 3)) * D + col) = cur;
                        asm volatile("" ::: "memory"); } } }
        }
    }
    __device__ __forceinline__ void custom_sk(int row, int r, int uc, int pn, int c, f32x4 v0, f32x4 v1, LAS float* T0, float rs) const {
        v0 = v0 * rs; v1 = v1 * rs;
        if (pn < 4) {
            v0 = gelu_tanh4(v0); v1 = gelu_tanh4(v1);
            st16_wt(R, WS_GG + blk_off(row, pn * 256 + c, D) * 2, pack8(v0, v1));
        } else { *(LAS f32x4*)(T0 + r * 132 + uc) = v0; *(LAS f32x4*)(T0 + r * 132 + uc + 4) = v1; }
        __syncthreads();
        if (pn >= 4) { const int rr = row - MP, t = rr & 3, bsm = rr >> 2, col = (pn - 4) * 256 + c;
            const float* cwp = KIN(12); const float* cbp = KIN(13); const float* cs = KIN(4);
            f32x4 x0 = *(const f32x4*)(cbp + col), x1 = *(const f32x4*)(cbp + col + 4);
            x0 = x0 + *(const f32x4*)(cwp + 3 * D + col) * v0; x1 = x1 + *(const f32x4*)(cwp + 3 * D + col + 4) * v1;
#pragma unroll
            for (int k = 1; k <= 3; ++k) { f32x4 h0, h1;
                if (t >= k) { h0 = *(const LAS f32x4*)(T0 + (r - k) * 132 + uc); h1 = *(const LAS f32x4*)(T0 + (r - k) * 132 + uc + 4); }
                else { const float* p = cs + ((size_t)bsm * 3 + (t + 3 - k)) * D + col; h0 = *(const f32x4*)p; h1 = *(const f32x4*)(p + 4); }
                x0 = x0 + *(const f32x4*)(cwp + (3 - k) * D + col) * h0; x1 = x1 + *(const f32x4*)(cwp + (3 - k) * D + col + 4) * h1; }
            st16_wt(R, WS_XC + blk_off(row, col, D) * 2, pack8(x0, x1));
            if (t >= 1) { float* o = out + OFF_NC_S + (size_t)(bsm * 3 + t - 1) * D + col; *(f32x4*)o = v0; *(f32x4*)(o + 4) = v1; } }
    }
};
struct OpGates { static constexpr bool CUSTOM = false, PAIRED = true, NEEDS_RSTD = false, HAS_SS = false, WANTS_MSQ = false; struct Pre { v4u w; };
    const bf16* XC; rsrc_t R; const float* SS; f32x4 brL[2], biL[2], c8[2];
    __device__ __forceinline__ void init() { unsigned char* ws = KWS(); XC = (const bf16*)(ws + WS_XC); R = ws_rsrc(ws); SS = nullptr; }
    __device__ __forceinline__ void prep(int pn, int c) { const int d0 = (pn >> 1) * 256 + (pn & 1) * 128 + c; const float* brg = KIN(15); const float* big = KIN(17); const float* lam = KIN(18);
#pragma unroll
        for (int e = 0; e < 8; ++e) { brL[e >> 2][e & 3] = LOG2E * brg[d0 + e]; biL[e >> 2][e & 3] = LOG2E * big[d0 + e]; const float ee = ex2(-lam[d0 + e] * LOG2E);
            const float sp = ee > 0.03f ? __logf(1.0f + ee) : ee * (1.0f + ee * (-0.5f + ee * (0.33333334f - 0.25f * ee))); c8[e >> 2][e & 3] = -8.0f * LOG2E * sp; } }
    __device__ __forceinline__ Pre preload(int row, int pn, int c) const { Pre p; p.w = *(const v4u*)(XC + blk_off(row, (pn >> 1) * 256 + (pn & 1) * 128 + c, D)); return p; }
    __device__ __forceinline__ void apply2(int row, int pn, int c, float, f32x4 r0, f32x4 r1, f32x4 i0, f32x4 i1, const Pre& p) const {
        const int d0 = (pn >> 1) * 256 + (pn & 1) * 128 + c;
        const v4u xw = p.w;
        const f32x4 xc[2] = {(f32x4){bflo(xw.x), bfhi(xw.x), bflo(xw.y), bfhi(xw.y)}, (f32x4){bflo(xw.z), bfhi(xw.z), bflo(xw.w), bfhi(xw.w)}};
        h16x8 la8, bb8;
#pragma unroll
        for (int hh = 0; hh < 2; ++hh) {
            const f32x4 tr = (hh ? r1 : r0) * LOG2E + brL[hh], ti = (hh ? i1 : i0) * LOG2E + biL[hh];
            const f32x4 er = (f32x4){ex2(-tr[0]), ex2(-tr[1]), ex2(-tr[2]), ex2(-tr[3])} + 1.0f, ei = (f32x4){ex2(-ti[0]), ex2(-ti[1]), ex2(-ti[2]), ex2(-ti[3])} + 1.0f;
            const f32x4 r = {rcpf_(er[0]), rcpf_(er[1]), rcpf_(er[2]), rcpf_(er[3])}, ig = {rcpf_(ei[0]), rcpf_(ei[1]), rcpf_(ei[2]), rcpf_(ei[3])};
            const f32x4 la2 = r * c8[hh];
            const f32x4 b = ig * xc[hh];
#pragma unroll
            for (int e = 0; e < 4; ++e) { la8[4 * hh + e] = (_Float16)la2[e]; bb8[4 * hh + e] = (_Float16)b[e]; } }
        st16_wt(R, WS_LA + blk_off(row, d0, D) * 2, __builtin_bit_cast(v4u, la8)); st16_wt(R, WS_BB + blk_off(row, d0, D) * 2, __builtin_bit_cast(v4u, bb8)); }
};
constexpr int RSB_OFF = LDSCTL_OFF + 1024 + 4096;
constexpr int RED_OFF = LDSCTL_OFF + 1024;
template <class Op> struct Epi8 { static constexpr bool PERM = true, AFTER_DRAIN = false, IDEMP = !Op::HAS_SS;
    LAS unsigned char* lds;
    __device__ __forceinline__ void first_unit(const Unit& u, int wid) const {
        if constexpr (Op::NEEDS_RSTD) { const int t = wid * 64 + lane_id_opaque();
            if (t < 256) { const float* sp = (const float*)(KWS() + WS_SS) + (unsigned)(u.pm * 256 + t) * 8u; ((LAS float*)(lds + RSB_OFF))[t] = msq_of(*(const f32x4*)sp, *(const f32x4*)(sp + 4)); } } }
    __device__ __forceinline__ void operator()(const f32x4 (&acc_in)[2][2][4][2], const Unit& u, const Unit& nu, bool has_next, int ui, int wr, int wc, int, int) const {
        const int lane_ = lane_id_opaque(), fr = lane_ & 15, fq = lane_ >> 4;
        Op op; op.init();
        const int pn = u.pn, c0 = wc * 32 + 8 * fq;
        op.prep(pn, c0);
#if (defined(PROBE_K2) && PROBE_K2) || (defined(PROBE_MMA2) && PROBE_MMA2)
        f32x4 acc[2][2][4][2];
#pragma unroll
        for (int a_ = 0; a_ < 2; ++a_)
#pragma unroll
            for (int b_ = 0; b_ < 2; ++b_)
#pragma unroll
                for (int m_ = 0; m_ < 4; ++m_)
#pragma unroll
                    for (int n_ = 0; n_ < 2; ++n_) acc[a_][b_][m_][n_] = acc_in[a_][b_][m_][n_] * 0.5f;
#else
        const f32x4 (&acc)[2][2][4][2] = acc_in;
#endif
        LAS float* red = (LAS float*)(lds + RED_OFF);
        f32x4 nsa = (f32x4){0.f, 0.f, 0.f, 0.f}, nsb = nsa;
        const int tq_ = (wr * 4 + wc) * 64 + lane_; const bool nprep_ = Op::NEEDS_RSTD && has_next && tq_ < 256;
        if constexpr (Op::NEEDS_RSTD) { if (nprep_) { const float* sp_ = op.SS + (unsigned)(nu.pm * 256 + tq_) * 8u; nsa = *(const f32x4*)sp_; nsb = *(const f32x4*)(sp_ + 4); } }
        float msv[2][4];
        if constexpr (Op::NEEDS_RSTD) { const LAS float* rsb_ = (const LAS float*)(lds + RSB_OFF) + (ui & 1) * 256 + wr * 64 + fr;
#pragma unroll
            for (int ai = 0; ai < 2; ++ai)
#pragma unroll
                for (int m = 0; m < 4; ++m) msv[ai][m] = rsb_[ai * 128 + m * 16]; }
        if constexpr (Op::CUSTOM) { float rsv[2][4];
#pragma unroll
            for (int ai = 0; ai < 2; ++ai)
#pragma unroll
                for (int m = 0; m < 4; ++m) rsv[ai][m] = __builtin_amdgcn_rsqf(msv[ai][m]);
            asm volatile("" ::: "memory");
            op.custom(acc, u, wr, wc, fr, fq, rsv);
            if (nprep_) ((LAS float*)(lds + RSB_OFF))[((ui + 1) & 1) * 256 + tq_] = msq_of(nsa, nsb);
            return; }
        typename Op::Pre pa[2][4], pb[2][4];
#pragma unroll
        for (int ai = 0; ai < 2; ++ai)
#pragma unroll
            for (int m = 0; m < 4; ++m) { const int row = u.pm * 256 + ai * 128 + wr * 64 + m * 16 + fr;
                pa[ai][m] = op.preload(row, pn, c0); if constexpr (!Op::PAIRED) pb[ai][m] = op.preload(row, pn, 128 + c0); }
#pragma unroll
        for (int ai = 0; ai < 2; ++ai) {
#pragma unroll
            for (int m = 0; m < 4; ++m) { const int rl = ai * 128 + wr * 64 + m * 16 + fr, row = u.pm * 256 + rl;
                float rs = 1.0f; if constexpr (Op::NEEDS_RSTD) rs = Op::WANTS_MSQ ? msv[ai][m] : __builtin_amdgcn_rsqf(msv[ai][m]);
                if constexpr (Op::PAIRED) op.apply2(row, pn, c0, rs, acc[ai][0][m][0], acc[ai][0][m][1], acc[ai][1][m][0], acc[ai][1][m][1], pa[ai][m]);
                else { float ssq = op.apply(row, pn, c0, rs, acc[ai][0][m][0], acc[ai][0][m][1], pa[ai][m]) + op.apply(row, pn, 128 + c0, rs, acc[ai][1][m][0], acc[ai][1][m][1], pb[ai][m]);
                    if constexpr (Op::HAS_SS) { ssq += __shfl_xor(ssq, 16); ssq += __shfl_xor(ssq, 32); if (fq == 0) red[rl * 4 + wc] = ssq; } } }
            asm volatile("" ::: "memory");
        }
        if constexpr (Op::NEEDS_RSTD) { if (nprep_) ((LAS float*)(lds + RSB_OFF))[((ui + 1) & 1) * 256 + tq_] = msq_of(nsa, nsb); }
        if constexpr (Op::HAS_SS) {
            asm volatile("s_waitcnt lgkmcnt(0)" ::: "memory"); __builtin_amdgcn_s_barrier(); asm volatile("" ::: "memory");
            const int t = (wr * 4 + wc) * 64 + lane_;
            if (t < 256) { const f32x4 r = *(const LAS f32x4*)(red + t * 4); *(f32x2*)(op.SS + (size_t)(u.pm * 256 + t) * 8 + 2 * pn) = (f32x2){r.x + r.y, r.z + r.w}; }
        }
    }
};
#ifndef PROBE_SK_RES
#define PROBE_SK_RES 0
#endif
#define SK_LOAD(fa, fb, bi) do { _Pragma("unroll") for (int i_ = 0; i_ < 4; ++i_) { fa[i_] = *(const bf16x8*)(ap + ((bi) * 2 + (i_ >> 1)) * 512 + 16 * (i_ & 1)); \
        fb[i_][0] = *(const bf16x8*)(bp + ((bi) * 2 + (i_ >> 1)) * 512 + 16 * (i_ & 1)); fb[i_][1] = *(const bf16x8*)(bp + (size_t)ldb * 32 + ((bi) * 2 + (i_ >> 1)) * 512 + 16 * (i_ & 1)); } } while (0)
#define SK_MMA(fa, fb) do { _Pragma("unroll") for (int i_ = 0; i_ < 4; ++i_) { acc0 = __builtin_amdgcn_mfma_f32_32x32x16_bf16(fa[i_], fb[i_][0], acc0, 0, 0, 0); acc1 = __builtin_amdgcn_mfma_f32_32x32x16_bf16(fa[i_], fb[i_][1], acc1, 0, 0, 0); } } while (0)
template <class Op, bool C64> __device__ __forceinline__ void skinny_phase(Frame& F, const bf16* A, int lda, int acol_shift, int acol_elems, const bf16* Bt, int ldb, int K, int npn, int kbeg, int kend) {
    static_assert(!C64 || (!Op::PAIRED && !Op::CUSTOM), "64-column units: plain ops only");
    static_assert(!Op::HAS_SS || C64, "row statistics of the sample rows: 16 slots, all rewritten by the 64-column units of a residual GEMM");
    constexpr int NS = C64 ? 8 : 4, TW = C64 ? 68 : 132, SK_T = 32 * TW, USH = C64 ? 6 : 5, JM = C64 ? 3 : 1;
    const int lane = lane_id_opaque(), wid = F.wave, tid = wid * 64 + lane;
    LAS float* T = (LAS float*)F.lds;
    const int kh = C64 ? wid : (wid & 3), cg = C64 ? 0 : (wid >> 2), r32 = lane & 31, hi = lane >> 5;
    const int nbt = K >> 6, nbase = nbt / NS, nrem = nbt - nbase * NS;
    const int nb = nbase + (kh < nrem ? 1 : 0), kst = (kh * nbase + (kh < nrem ? kh : nrem)) * 64;
    bf16x8 a0[4], b0[4][2], a1[4], b1[4][2], a2[4], b2[4][2];
    const bf16* ap = A; const bf16* bp = Bt;
#define SK_SETUP(uu) do { const int pn_ = (uu) >> USH, j_ = ((uu) >> 4) & JM, rb_ = (uu) & 15; \
        { const int m_ = MP + 32 * rb_ + r32; ap = A + ((size_t)(m_ >> 4) * (lda >> 5) + (((pn_ >> acol_shift) * acol_elems + kst) >> 5)) * 512 + (m_ & 15) * 32 + 8 * hi; } \
        { const int n_ = pn_ * 256 + (C64 ? 64 * j_ : (cg == 0 ? 64 * j_ : 128 + 64 * j_)) + r32; bp = Bt + ((size_t)(n_ >> 4) * (ldb >> 5) + (kst >> 5)) * 512 + (n_ & 15) * 32 + 8 * hi; } } while (0)
    if (kbeg >= kend) return;
    { SK_SETUP(F.vcu + kbeg * F.G); SK_LOAD(a0, b0, 0); if (nb > 1) SK_LOAD(a1, b1, 1); }
    const int uend = F.vcu + kend * F.G;
    for (int u = F.vcu + kbeg * F.G; u < uend; u += F.G) {
        const int pn = u >> USH, j = (u >> 4) & JM, rb = u & 15;
        Op op; op.init();
        const bool eact_ = !C64 || tid < 256;
        const int er_ = C64 ? ((tid >> 3) & 31) : (tid >> 4), egrp_ = C64 ? (tid & 7) : (tid & 15), erow_ = MP + 32 * rb + er_;
        const int ec_ = C64 ? 64 * j + 8 * egrp_ : (Op::PAIRED ? 64 * j + 8 * (egrp_ & 7) : (egrp_ < 8 ? 64 * j + 8 * egrp_ : 128 + 64 * j + 8 * egrp_ - 64));
        f32x4 ess0_ = (f32x4){0.f, 0.f, 0.f, 0.f}, ess1_ = ess0_;
        if constexpr (Op::NEEDS_RSTD) { const float* sp_ = (const float*)(KWS() + WS_SSS) + (size_t)(erow_ - MP) * 16;
            ess0_ = *(const f32x4*)sp_ + *(const f32x4*)(sp_ + 4); ess1_ = *(const f32x4*)(sp_ + 8) + *(const f32x4*)(sp_ + 12); }
        typename Op::Pre epre_ = op.preload(erow_, pn, ec_);
        f32x16 acc0 = {}, acc1 = {};
        if (nb > 2) SK_LOAD(a2, b2, 2);
        for (int b = 0;;) {
            __builtin_amdgcn_sched_barrier(0); SK_MMA(a0, b0); __builtin_amdgcn_sched_barrier(0);
            if (b + 3 < nb) SK_LOAD(a0, b0, b + 3);
            if (++b >= nb) break;
            __builtin_amdgcn_sched_barrier(0); SK_MMA(a1, b1); __builtin_amdgcn_sched_barrier(0);
            if (b + 3 < nb) SK_LOAD(a1, b1, b + 3);
            if (++b >= nb) break;
            __builtin_amdgcn_sched_barrier(0); SK_MMA(a2, b2); __builtin_amdgcn_sched_barrier(0);
            if (b + 3 < nb) SK_LOAD(a2, b2, b + 3);
            if (++b >= nb) break;
        }
        if (u + F.G < uend) { SK_SETUP(u + F.G); SK_LOAD(a0, b0, 0); if (nb > 1) SK_LOAD(a1, b1, 1); }
#pragma unroll
        for (int i = 0; i < 16; ++i) { const int rr = (i & 3) + 8 * (i >> 2) + 4 * hi; T[kh * SK_T + rr * TW + 64 * cg + r32] = acc0[i]; T[kh * SK_T + rr * TW + 64 * cg + 32 + r32] = acc1[i]; }
        __syncthreads();
        { const int r = er_, grp = egrp_, row = erow_;
#define SK_SUM4(p) (*(const LAS f32x4*)(p) + *(const LAS f32x4*)((p) + SK_T) + *(const LAS f32x4*)((p) + 2 * SK_T) + *(const LAS f32x4*)((p) + 3 * SK_T))
#define SK_SUMS(p) (C64 ? (SK_SUM4(p) + SK_SUM4((p) + 4 * SK_T)) : SK_SUM4(p))
          if constexpr (Op::CUSTOM) {
              const int uc = 8 * grp, c = uc < 64 ? 64 * j + uc : 128 + 64 * j + uc - 64;
              const LAS float* t0 = T + r * TW + uc;
              const f32x4 v0 = SK_SUM4(t0), v1 = SK_SUM4(t0 + 4);
              op.custom_sk(row, r, uc, pn, c, v0, v1, T, rstd_of(ess0_, ess1_));
          } else if constexpr (Op::PAIRED) {
              if (grp < 8) { const int c = 64 * j + 8 * grp; op.prep(pn, c);
                  const LAS float* t0 = T + r * TW + 8 * grp;
                  const f32x4 g0 = SK_SUM4(t0), g1 = SK_SUM4(t0 + 4), u0 = SK_SUM4(t0 + 64), u1 = SK_SUM4(t0 + 68);
                  float rs = 1.0f; if constexpr (Op::NEEDS_RSTD) rs = Op::WANTS_MSQ ? msq_of(ess0_, ess1_) : rstd_of(ess0_, ess1_);
                  op.apply2(row, pn, c, rs, g0, g1, u0, u1, epre_); }
          } else if (eact_) {
              const int uc = 8 * grp, c = ec_; op.prep(pn, c);
              const LAS float* t0 = T + r * TW + uc;
              f32x4 v0 = SK_SUMS(t0), v1 = SK_SUMS(t0 + 4);
              if (PROBE_SK_RES && F.dry) { v0 = v0 * 0.f; v1 = v1 * 0.f; }
              float rs = 1.0f; if constexpr (Op::NEEDS_RSTD) rs = rstd_of(ess0_, ess1_);
              float ssq = op.apply(row, pn, c, rs, v0, v1, epre_);
              if constexpr (Op::HAS_SS) { ssq += __shfl_xor(ssq, 1); ssq += __shfl_xor(ssq, 2); ssq += __shfl_xor(ssq, 4); if constexpr (!C64) ssq += __shfl_xor(ssq, 8);
                  if (grp == 0) ((float*)(KWS() + WS_SSS))[(size_t)(row - MP) * 16 + (C64 ? 4 * pn + j : 2 * pn + j)] = ssq; }
          } }
#undef SK_SUM4
#undef SK_SUMS
        __syncthreads();
    }
#undef SK_SETUP
}
__device__ __forceinline__ int crow(int r, int hi) { return (r & 3) + 8 * (r >> 2) + 4 * hi; }
typedef short v4i16_t __attribute__((ext_vector_type(4)));
__device__ __forceinline__ s16x4 vtr(LAS const unsigned char* p) { return __builtin_bit_cast(s16x4, __builtin_amdgcn_ds_read_tr16_b64_v4i16((LAS v4i16_t*)p)); }
constexpr int AT_KS = 0, AT_VS = 27648, AT_WSF = 55296, AT_OST = 56320, AT_ROWB = 144;
constexpr int AT_NU = BATCH * 128 * NKV;
struct AttnPre { v4u kv[3], vv[3]; bf16x8 qr[4]; };
__device__ __forceinline__ void attn_prefetch(AttnPre& P, int u, int tid, int wid, int r32, int hi, const bf16* Q, const bf16* Kb, const bf16* Vb) {
    const int g = u & 3, qb = (u >> 2) & 127, b = u >> 9; const int t0 = qb * 64 - 128; const size_t rowbase = (size_t)b * SEQ;
#pragma unroll
    for (int i = 0; i < 3; ++i) { const int idx = tid + 512 * i, r = idx >> 3, ch = idx & 7, t = t0 + r;
        P.kv[i] = (v4u){0u, 0u, 0u, 0u}; P.vv[i] = (v4u){0u, 0u, 0u, 0u};
        if (t >= 0) { const size_t o_ = blk_off((int)rowbase + t, g * 64 + ch * 8, 256); P.kv[i] = *(const v4u*)(Kb + o_); P.vv[i] = *(const v4u*)(Vb + o_); } }
    const int h = 4 * g + (wid >> 1), tq0 = qb * 64 + 32 * (wid & 1);
#pragma unroll
    for (int d0 = 0; d0 < 4; ++d0) P.qr[d0] = *(const bf16x8*)(Q + blk_off((int)rowbase + tq0 + r32, h * 64 + d0 * 16 + hi * 8, D));
}
__device__ __forceinline__ void attn_prompt_units(Frame& F, const bf16* Q, const bf16* Kb, const bf16* Vb, bf16* O, const float* sinks) {
    const int lane = lane_id_opaque(), wid = F.wave, tid = wid * 64 + lane, r32 = lane & 31, hi = lane >> 5;
    LAS unsigned char* lds = F.lds;
    AttnPre P;
    int u = F.vcu;
    if (u < AT_NU) attn_prefetch(P, u, tid, wid, r32, hi, Q, Kb, Vb);
    for (; u < AT_NU; u += F.G) {
    const int g = u & 3, qb = (u >> 2) & 127, b = u >> 9; const size_t rowbase = (size_t)b * SEQ;
#pragma unroll
    for (int i = 0; i < 3; ++i) { const int idx = tid + 512 * i, r = idx >> 3, ch = idx & 7;
        *(LAS v4u*)(lds + AT_KS + r * AT_ROWB + ch * 16) = P.kv[i]; *(LAS v4u*)(lds + AT_VS + r * AT_ROWB + ch * 16) = P.vv[i]; }
    bf16x8 qr[4];
#pragma unroll
    for (int d0 = 0; d0 < 4; ++d0) qr[d0] = P.qr[d0];
    __syncthreads();
    if (u + F.G < AT_NU) attn_prefetch(P, u + F.G, tid, wid, r32, hi, Q, Kb, Vb);
    const int h = 4 * g + (wid >> 1), s = wid & 1, tq0 = qb * 64 + 32 * s;
    f32x16 p[5];
#pragma unroll
    for (int c = 0; c < 5; ++c) { f32x16 a = {};
#pragma unroll
        for (int d0 = 0; d0 < 4; ++d0) { const bf16x8 kf = *(const LAS bf16x8*)(lds + AT_KS + (32 * s + 32 * c + r32) * AT_ROWB + (d0 * 16 + hi * 8) * 2); a = __builtin_amdgcn_mfma_f32_32x32x16_bf16(kf, qr[d0], a, 0, 0, 0); }
        p[c] = a; }
    const float slope2 = ex2(-0.5f * (float)(h + 1)) * LOG2E, sink2 = sinks[h] * LOG2E;
    int base = r32 - 4 * hi + 128; asm volatile("" : "+v"(base));
    const float sb = slope2 * (float)base; const int kmin = 128 - tq0 - 4 * hi; const bool head = tq0 < 128;
#pragma unroll
    for (int c = 0; c < 5; ++c)
#pragma unroll
        for (int r = 0; r < 16; ++r) { const int kc = 32 * c + (r & 3) + 8 * (r >> 2);
            float x = fmaf(slope2, (float)kc, p[c][r]) - sb;
            if (c == 0) x = (kc >= base - 128) ? x : -1e30f;
            if (c == 4) x = (kc <= base) ? x : -1e30f;
            p[c][r] = x; }
    if (head) {
#pragma unroll
        for (int c = 0; c < 5; ++c)
#pragma unroll
            for (int r = 0; r < 16; ++r) { const int kc = 32 * c + (r & 3) + 8 * (r >> 2); p[c][r] = (kc >= kmin) ? p[c][r] : -1e30f; } }
    float mx = sink2;
#pragma unroll
    for (int c = 0; c < 5; ++c)
#pragma unroll
        for (int r = 0; r < 16; ++r) mx = fmaxf(mx, p[c][r]);
    mx = fmaxf(mx, __shfl_xor(mx, 32));
    float l = 0.f;
#pragma unroll
    for (int c = 0; c < 5; ++c)
#pragma unroll
        for (int r = 0; r < 16; ++r) { const float e = ex2(p[c][r] - mx); p[c][r] = e; l += e; }
    l += __shfl_xor(l, 32); l += ex2(sink2 - mx);
    f32x16 o[2]; o[0] = f32x16{}; o[1] = f32x16{};
    const int vlane = (4 * hi + ((lane & 15) >> 2)) * AT_ROWB + 32 * ((lane >> 4) & 1) + 8 * (lane & 3);
#pragma unroll
    for (int c = 0; c < 5; ++c)
#pragma unroll
        for (int s2 = 0; s2 < 2; ++s2) {
            v4u pw; pw.x = pk2(p[c][8 * s2 + 0], p[c][8 * s2 + 1]); pw.y = pk2(p[c][8 * s2 + 2], p[c][8 * s2 + 3]); pw.z = pk2(p[c][8 * s2 + 4], p[c][8 * s2 + 5]); pw.w = pk2(p[c][8 * s2 + 6], p[c][8 * s2 + 7]);
            const bf16x8 pa = __builtin_bit_cast(bf16x8, pw);
            const int krow0 = 32 * s + 32 * c + 16 * s2;
#pragma unroll
            for (int dh = 0; dh < 2; ++dh) {
                const s16x4 vlo = vtr(lds + AT_VS + krow0 * AT_ROWB + vlane + 64 * dh), vhi = vtr(lds + AT_VS + (krow0 + 8) * AT_ROWB + vlane + 64 * dh);
                const bf16x8 vf = (bf16x8){vlo[0], vlo[1], vlo[2], vlo[3], vhi[0], vhi[1], vhi[2], vhi[3]};
                o[dh] = __builtin_amdgcn_mfma_f32_32x32x16_bf16(pa, vf, o[dh], 0, 0, 0); }
        }
    LAS float* wsf = (LAS float*)(lds + AT_WSF) + wid * 32;
    if (hi == 0) wsf[r32] = 1.0f / l;
    LDS_WAIT(); asm volatile("" ::: "memory");
    LAS unsigned short* stg = (LAS unsigned short*)(lds + AT_OST + wid * 4352);
#pragma unroll
    for (int r = 0; r < 16; ++r) { const int q = crow(r, hi); const float inv = wsf[q];
        stg[q * 68 + r32] = (unsigned short)(pk2(o[0][r] * inv, 0.f) & 0xffffu); stg[q * 68 + 32 + r32] = (unsigned short)(pk2(o[1][r] * inv, 0.f) & 0xffffu); }
    LDS_WAIT(); asm volatile("" ::: "memory");
#pragma unroll
    for (int i = 0; i < 4; ++i) { const int id = lane + 64 * i, row = id >> 3, ch = id & 7;
        const v2u lo = *(const LAS v2u*)(stg + row * 68 + ch * 8), hi2 = *(const LAS v2u*)(stg + row * 68 + ch * 8 + 4);
        *(v4u*)(O + blk_off((int)(rowbase + tq0) + row, h * 64 + ch * 8, D)) = (v4u){lo.x, lo.y, hi2.x, hi2.y}; }
    __syncthreads();
    }
}
__device__ __forceinline__ void attn_sample_task(Frame& F, int b, int g, int t, const bf16* Q, const bf16* Kb, const bf16* Vb, bf16* O, const float* ck, const float* cv, const float* sinks) {
    const int lane = lane_id_opaque();
    LAS float* Qs = (LAS float*)(F.lds + F.wave * 4096); LAS float* Pt = Qs + 256;
#pragma unroll
    for (int i = 0; i < 4; ++i) Qs[i * 64 + lane] = bf2f(Q[blk_off(MP + 4 * b + t, (4 * g + i) * 64 + lane, D)]);
    LDS_WAIT(); asm volatile("" ::: "memory");
    for (int j = 0; j < 3; ++j) { const int si = lane + 64 * j;
        if (si < 132) {
            float kv[64];
            if (si < 128) { const f32x4* kp = (const f32x4*)(ck + ((size_t)(b * 128 + si) * 4 + g) * 64);
#pragma unroll
                for (int e = 0; e < 16; ++e) { const f32x4 v = kp[e]; kv[4 * e] = v.x; kv[4 * e + 1] = v.y; kv[4 * e + 2] = v.z; kv[4 * e + 3] = v.w; } }
            else { const int kr_ = MP + 4 * b + si - 128;
#pragma unroll
                for (int e = 0; e < 8; ++e) { const v4u w = *(const v4u*)(Kb + blk_off(kr_, g * 64 + 8 * e, 256)); kv[8 * e] = bflo(w.x); kv[8 * e + 1] = bfhi(w.x); kv[8 * e + 2] = bflo(w.y); kv[8 * e + 3] = bfhi(w.y); kv[8 * e + 4] = bflo(w.z); kv[8 * e + 5] = bfhi(w.z); kv[8 * e + 6] = bflo(w.w); kv[8 * e + 7] = bfhi(w.w); } }
            const int dist = t - si + 128; const bool valid = dist >= 0 && dist <= 128;
            f32x4 sc;
#pragma unroll
            for (int i = 0; i < 4; ++i) { float dt = 0.f;
#pragma unroll
                for (int e = 0; e < 16; ++e) { const f32x4 qv = *(const LAS f32x4*)(Qs + i * 64 + 4 * e); dt += kv[4 * e] * qv.x + kv[4 * e + 1] * qv.y + kv[4 * e + 2] * qv.z + kv[4 * e + 3] * qv.w; }
                const float slope2 = ex2(-0.5f * (float)(4 * g + i + 1)) * LOG2E;
                sc[i] = valid ? dt - slope2 * (float)dist : -1e30f; }
            *(LAS f32x4*)(Pt + si * 4) = sc;
        }
    }
    LDS_WAIT(); asm volatile("" ::: "memory");
    f32x4 x0 = *(const LAS f32x4*)(Pt + lane * 4), x1 = *(const LAS f32x4*)(Pt + (lane + 64) * 4), x2 = lane < 4 ? *(const LAS f32x4*)(Pt + (lane + 128) * 4) : (f32x4){-1e30f, -1e30f, -1e30f, -1e30f};
    float linv[4];
#pragma unroll
    for (int i = 0; i < 4; ++i) { const float sink2 = sinks[4 * g + i] * LOG2E;
        const float mx = fmaxf(wave_max(fmaxf(fmaxf(x0[i], x1[i]), x2[i])), sink2);
        x0[i] = ex2(x0[i] - mx); x1[i] = ex2(x1[i] - mx); x2[i] = ex2(x2[i] - mx);
        linv[i] = 1.0f / (wave_sum(x0[i] + x1[i] + x2[i]) + ex2(sink2 - mx)); }
    *(LAS f32x4*)(Pt + lane * 4) = x0; *(LAS f32x4*)(Pt + (lane + 64) * 4) = x1; if (lane < 4) *(LAS f32x4*)(Pt + (lane + 128) * 4) = x2;
    LDS_WAIT(); asm volatile("" ::: "memory");
    float o0 = 0.f, o1 = 0.f, o2 = 0.f, o3 = 0.f;
    const float* cvp = cv + ((size_t)(b * 128) * 4 + g) * 64 + lane;
#pragma unroll 1
    for (int s0 = 0; s0 < 128; s0 += 32) {
        float v[32];
#pragma unroll
        for (int k = 0; k < 32; ++k) v[k] = cvp[(size_t)(s0 + k) * 256];
#pragma unroll
        for (int k = 0; k < 32; ++k) { const f32x4 pv = *(const LAS f32x4*)(Pt + (s0 + k) * 4); o0 += pv.x * v[k]; o1 += pv.y * v[k]; o2 += pv.z * v[k]; o3 += pv.w * v[k]; }
    }
#pragma unroll
    for (int k = 0; k < 4; ++k) { const float v = bf2f(Vb[blk_off(MP + 4 * b + k, g * 64 + lane, 256)]); const f32x4 pv = *(const LAS f32x4*)(Pt + (128 + k) * 4); o0 += pv.x * v; o1 += pv.y * v; o2 += pv.z * v; o3 += pv.w * v; }
    { const int orow = MP + 4 * b + t, oc = (4 * g) * 64 + lane;
      O[blk_off(orow, oc, D)] = (bf16)f2bf(o0 * linv[0]); O[blk_off(orow, oc + 64, D)] = (bf16)f2bf(o1 * linv[1]); O[blk_off(orow, oc + 128, D)] = (bf16)f2bf(o2 * linv[2]); O[blk_off(orow, oc + 192, D)] = (bf16)f2bf(o3 * linv[3]); }
    LDS_WAIT(); asm volatile("" ::: "memory");
}
__device__ __forceinline__ void attn_phase(Frame& F) {
    unsigned char* ws = KWS();
    const bf16* Q = (const bf16*)(ws + WS_Q); const bf16* Kb = (const bf16*)(ws + WS_K); const bf16* Vb = (const bf16*)(ws + WS_V); bf16* O = (bf16*)(ws + WS_O);
    for (int task = F.wave * F.G + (int)blockIdx.x; task < DECB * NKV * DECT; task += NWAVES * F.G) attn_sample_task(F, task >> 4, (task >> 2) & 3, task & 3, Q, Kb, Vb, O, KIN(2), KIN(3), KIN(9));
    __syncthreads();
    attn_prompt_units(F, Q, Kb, Vb, O, KIN(9));
}

__device__ __forceinline__ void conv_fixup(Frame& F, int bx) {
    unsigned char* ws = KWS(); const bf16* XBC = (const bf16*)(ws + WS_XBC); bf16* XC = (bf16*)(ws + WS_XC);
    const float* cwp = KIN(12); const float* cbp = KIN(13);
    const int tid = F.wave * 64 + lane_id_opaque(), ri = tid >> 5, chunk = tid & 31;
    pg8::StaticOrder S; S.init(MP, 2048, F.G, bx, WGM_OF(2048, 256));
    pg8::Unit u;
    for (int i = 0; S.next(i, u); ++i) {
        if (ri < 12) { const int row = u.pm * 256 + 64 * (ri / 3) + (ri % 3), t = row & (SEQ - 1), col = (u.pn >> 1) * 256 + 8 * chunk;
            f32x4 x0 = *(const f32x4*)(cbp + col), x1 = *(const f32x4*)(cbp + col + 4);
#pragma unroll
            for (int k = 0; k <= 3; ++k) {
                if (t - k >= 0) { const v4u w = *(const v4u*)(XBC + (size_t)(row - k) * D + col);
                    x0 = x0 + *(const f32x4*)(cwp + (3 - k) * D + col) * (f32x4){bflo(w.x), bfhi(w.x), bflo(w.y), bfhi(w.y)};
                    x1 = x1 + *(const f32x4*)(cwp + (3 - k) * D + col + 4) * (f32x4){bflo(w.z), bfhi(w.z), bflo(w.w), bfhi(w.w)}; } }
            *(v4u*)(XC + blk_off(row, col, D)) = pack8(x0, x1); }
    }
    VM_WAIT(); __syncthreads();
}

constexpr int SCH = 128, NSCH = SEQ / SCH;
__device__ __forceinline__ void scan1_phase(Frame& F) {
    unsigned char* ws = KWS(); const _Float16* LA = (const _Float16*)(ws + WS_LA); const _Float16* BB = (const _Float16*)(ws + WS_BB);
    float* SLA = (float*)(ws + WS_SLA); float* HT = (float*)(ws + WS_HT); float* SUBS = (float*)(ws + WS_SUBS); float* SUBH = (float*)(ws + WS_SUBH);
    const int tid = F.wave * 64 + lane_id_opaque(), q = tid >> 7, cg = tid & 127, d = 8 * cg;
    LAS float* P = (LAS float*)F.lds;
    for (int u = F.vcu; u < BATCH * NSCH; u += F.G) {
        const int row0 = u * SCH + 32 * q;
        float S[8], H[8];
#pragma unroll
        for (int e = 0; e < 8; ++e) { S[e] = 0.f; H[e] = 0.f; }
#define SC1_LOAD(la_, bb_, i0_) do { _Pragma("unroll") for (int r_ = 0; r_ < 4; ++r_) { const unsigned o_ = blk_off(row0 + (i0_) + r_, d, D); la_[r_] = *(const h16x8*)(LA + o_); bb_[r_] = *(const h16x8*)(BB + o_); } } while (0)
#define SC1_FOLD(la_, bb_) do { _Pragma("unroll") for (int r_ = 0; r_ < 4; ++r_) { _Pragma("unroll") for (int e = 0; e < 8; ++e) { const float l = (float)la_[r_][e]; S[e] += l; const float a = ex2(l); \
            H[e] = a * H[e] + __builtin_amdgcn_sqrtf(fmaf(-a, a, 1.0f)) * (float)bb_[r_][e]; } } } while (0)
        { h16x8 laA[4], bbA[4], laB[4], bbB[4];
          SC1_LOAD(laA, bbA, 0);
#pragma unroll 1
          for (int i = 0; i < 32; i += 8) {
              SC1_LOAD(laB, bbB, i + 4); __builtin_amdgcn_sched_barrier(0);
              SC1_FOLD(laA, bbA); __builtin_amdgcn_sched_barrier(0);
              if (i + 8 < 32) SC1_LOAD(laA, bbA, i + 8);
              __builtin_amdgcn_sched_barrier(0);
              SC1_FOLD(laB, bbB); __builtin_amdgcn_sched_barrier(0); } }
#undef SC1_LOAD
#undef SC1_FOLD
        { float* ps = SUBS + (size_t)(u * 4 + q) * D + d; float* ph = SUBH + (size_t)(u * 4 + q) * D + d;
          *(f32x4*)ps = (f32x4){S[0], S[1], S[2], S[3]}; *(f32x4*)(ps + 4) = (f32x4){S[4], S[5], S[6], S[7]}; *(f32x4*)ph = (f32x4){H[0], H[1], H[2], H[3]}; *(f32x4*)(ph + 4) = (f32x4){H[4], H[5], H[6], H[7]}; }
#pragma unroll
        for (int e = 0; e < 8; ++e) { P[(q * 128 + cg) * 16 + e] = S[e]; P[(q * 128 + cg) * 16 + 8 + e] = H[e]; }
        __syncthreads();
        if (q == 0) { float St[8], Ht[8];
#pragma unroll
            for (int e = 0; e < 8; ++e) { St[e] = 0.f; Ht[e] = 0.f; }
#pragma unroll
            for (int w = 0; w < 4; ++w)
#pragma unroll
                for (int e = 0; e < 8; ++e) { const float s2 = P[(w * 128 + cg) * 16 + e], h2 = P[(w * 128 + cg) * 16 + 8 + e]; St[e] += s2; Ht[e] = Ht[e] * ex2(s2) + h2; }
            float* ps = SLA + (size_t)u * D + d; float* ph = HT + (size_t)u * D + d;
            *(f32x4*)ps = (f32x4){St[0], St[1], St[2], St[3]}; *(f32x4*)(ps + 4) = (f32x4){St[4], St[5], St[6], St[7]}; *(f32x4*)ph = (f32x4){Ht[0], Ht[1], Ht[2], Ht[3]}; *(f32x4*)(ph + 4) = (f32x4){Ht[4], Ht[5], Ht[6], Ht[7]}; }
        __syncthreads();
    }
}
__device__ __forceinline__ void scan2_phase(Frame& F) {
    unsigned char* ws = KWS(); const _Float16* LA = (const _Float16*)(ws + WS_LA); const _Float16* BB = (const _Float16*)(ws + WS_BB);
    const bf16* GG = (const bf16*)(ws + WS_GG); bf16* A2 = (bf16*)(ws + WS_XBC);
    const float* SLA = (const float*)(ws + WS_SLA); const float* HT = (const float*)(ws + WS_HT); const float* SUBS = (const float*)(ws + WS_SUBS); const float* SUBH = (const float*)(ws + WS_SUBH);
    const int tid = F.wave * 64 + lane_id_opaque(), q = tid >> 7, cg = tid & 127, d = 8 * cg;
    LAS float* C = (LAS float*)F.lds;
    for (int u = F.vcu; u < BATCH * NSCH + DECB / 4; u += F.G) {
        float h[8]; int row0, nrow;
        if (u < BATCH * NSCH) {
            const int b = u / NSCH, c = u % NSCH;
            {
                float Sp[8], Hp[8];
#pragma unroll
                for (int e = 0; e < 8; ++e) { Sp[e] = 0.f; Hp[e] = 0.f; }
                const int c0 = (c * q) >> 2, c1 = (c * (q + 1)) >> 2;
#pragma unroll 8
                for (int cc = c0; cc < c1; ++cc) { const float* ps = SLA + (size_t)(b * NSCH + cc) * D + d; const float* ph = HT + (size_t)(b * NSCH + cc) * D + d;
                    const f32x4 s0 = *(const f32x4*)ps, s1 = *(const f32x4*)(ps + 4), t0 = *(const f32x4*)ph, t1 = *(const f32x4*)(ph + 4);
#pragma unroll
                    for (int e = 0; e < 4; ++e) { Hp[e] = ex2(s0[e]) * Hp[e] + t0[e]; Hp[4 + e] = ex2(s1[e]) * Hp[4 + e] + t1[e]; Sp[e] += s0[e]; Sp[4 + e] += s1[e]; } }
#pragma unroll
                for (int e = 0; e < 8; ++e) { C[(q * 128 + cg) * 16 + e] = Sp[e]; C[(q * 128 + cg) * 16 + 8 + e] = Hp[e]; }
            }
            __syncthreads();
#pragma unroll
            for (int e = 0; e < 8; ++e) h[e] = 0.f;
#pragma unroll
            for (int w = 0; w < 4; ++w)
#pragma unroll
                for (int e = 0; e < 8; ++e) { const float s2 = C[(w * 128 + cg) * 16 + e], h2 = C[(w * 128 + cg) * 16 + 8 + e]; h[e] = h[e] * ex2(s2) + h2; }
            for (int qq = 0; qq < q; ++qq) { const float* ps = SUBS + (size_t)(u * 4 + qq) * D + d; const float* ph = SUBH + (size_t)(u * 4 + qq) * D + d;
                const f32x4 s0 = *(const f32x4*)ps, s1 = *(const f32x4*)(ps + 4), t0 = *(const f32x4*)ph, t1 = *(const f32x4*)(ph + 4);
#pragma unroll
                for (int e = 0; e < 4; ++e) { h[e] = ex2(s0[e]) * h[e] + t0[e]; h[4 + e] = ex2(s1[e]) * h[4 + e] + t1[e]; } }
            row0 = u * SCH + 32 * q; nrow = 32;
        } else { const int b = (u - BATCH * NSCH) * 4 + q; const float* hp = KIN(5) + (size_t)b * D + d; const f32x4 a0 = *(const f32x4*)hp, a1 = *(const f32x4*)(hp + 4);
#pragma unroll
            for (int e = 0; e < 4; ++e) { h[e] = a0[e]; h[4 + e] = a1[e]; }
            row0 = MP + 4 * b; nrow = 4; __syncthreads(); }
#define SC2_LOAD(la_, bb_, gw_, i0_) do { _Pragma("unroll") for (int r_ = 0; r_ < 4; ++r_) { const unsigned o_ = blk_off(row0 + (i0_) + r_, d, D); la_[r_] = *(const h16x8*)(LA + o_); bb_[r_] = *(const h16x8*)(BB + o_); gw_[r_] = *(const v4u*)(GG + o_); } } while (0)
#define SC2_SCAN(la_, bb_, gw_, i0_) do { _Pragma("unroll") for (int r_ = 0; r_ < 4; ++r_) { const v4u gw = gw_[r_]; \
            const float gg[8] = {bflo(gw.x), bfhi(gw.x), bflo(gw.y), bfhi(gw.y), bflo(gw.z), bfhi(gw.z), bflo(gw.w), bfhi(gw.w)}; float o[8]; \
            _Pragma("unroll") for (int e = 0; e < 8; ++e) { const float a = ex2((float)la_[r_][e]); h[e] = a * h[e] + __builtin_amdgcn_sqrtf(fmaf(-a, a, 1.0f)) * (float)bb_[r_][e]; o[e] = h[e] * gg[e]; } \
            *(v4u*)(A2 + blk_off(row0 + (i0_) + r_, d, D)) = pack8((f32x4){o[0], o[1], o[2], o[3]}, (f32x4){o[4], o[5], o[6], o[7]}); } } while (0)
        { h16x8 laA[4], bbA[4], laB[4], bbB[4]; v4u gwA[4], gwB[4];
          SC2_LOAD(laA, bbA, gwA, 0);
#pragma unroll 1
          for (int i = 0; i < nrow; i += 8) {
              if (i + 4 < nrow) SC2_LOAD(laB, bbB, gwB, i + 4);
              __builtin_amdgcn_sched_barrier(0);
              SC2_SCAN(laA, bbA, gwA, i); __builtin_amdgcn_sched_barrier(0);
              if (i + 4 < nrow) {
                  if (i + 8 < nrow) SC2_LOAD(laA, bbA, gwA, i + 8);
                  __builtin_amdgcn_sched_barrier(0);
                  SC2_SCAN(laB, bbB, gwB, i + 4); __builtin_amdgcn_sched_barrier(0); } } }
#undef SC2_LOAD
#undef SC2_SCAN
        float* nh = nullptr;
        if (u < BATCH * NSCH) { if ((u % NSCH) == NSCH - 1 && q == 3) nh = KOUT() + OFF_NH_P + (size_t)(u / NSCH) * D + d; }
        else nh = KOUT() + OFF_NH_S + (size_t)((u - BATCH * NSCH) * 4 + q) * D + d;
        if (nh) { *(f32x4*)nh = (f32x4){h[0], h[1], h[2], h[3]}; *(f32x4*)(nh + 4) = (f32x4){h[4], h[5], h[6], h[7]}; }
        __syncthreads();
    }
}
__device__ __forceinline__ void final_norm_phase(Frame& F) {
    unsigned char* ws = KWS(); const float* SS = (const float*)(ws + WS_SS); const bf16* XB = (const bf16*)(ws + WS_XB); const float* g = KIN(23); float* out = KOUT();
    const int lane = lane_id_opaque();
    const int gw = F.vcu * NWAVES + F.wave, NGW = F.G * NWAVES;
    f32x4 gv[2][2];
#pragma unroll
    for (int j = 0; j < 2; ++j) { gv[j][0] = *(const f32x4*)(g + 8 * lane + 512 * j); gv[j][1] = *(const f32x4*)(g + 8 * lane + 512 * j + 4); }
    for (int m0 = 2 * gw; m0 < M; m0 += 2 * NGW) {
        float rs0, rs1;
        if (m0 < MP) { rs0 = rstd_of(*(const f32x4*)(SS + (size_t)m0 * 8), *(const f32x4*)(SS + (size_t)m0 * 8 + 4));
            rs1 = rstd_of(*(const f32x4*)(SS + (size_t)(m0 + 1) * 8), *(const f32x4*)(SS + (size_t)(m0 + 1) * 8 + 4)); }
        else { const float* sp = (const float*)(ws + WS_SSS) + (size_t)(m0 - MP) * 16;
            rs0 = rstd_of(*(const f32x4*)sp + *(const f32x4*)(sp + 4), *(const f32x4*)(sp + 8) + *(const f32x4*)(sp + 12));
            rs1 = rstd_of(*(const f32x4*)(sp + 16) + *(const f32x4*)(sp + 20), *(const f32x4*)(sp + 24) + *(const f32x4*)(sp + 28)); }
        v4u w0[2], w1[2];
#pragma unroll
        for (int j = 0; j < 2; ++j) { const int col = 8 * lane + 512 * j; w0[j] = *(const GAS v4u*)(XB + blk_off(m0, col, D)); w1[j] = *(const GAS v4u*)(XB + blk_off(m0 + 1, col, D)); }
#pragma unroll
        for (int j = 0; j < 2; ++j) { const int col = 8 * lane + 512 * j; float* y0 = out + (size_t)m0 * D + col; float* y1 = y0 + D;
            *(GAS f32x4*)y0 = (f32x4){bflo(w0[j].x), bfhi(w0[j].x), bflo(w0[j].y), bfhi(w0[j].y)} * rs0 * gv[j][0]; *(GAS f32x4*)(y0 + 4) = (f32x4){bflo(w0[j].z), bfhi(w0[j].z), bflo(w0[j].w), bfhi(w0[j].w)} * rs0 * gv[j][1];
            *(GAS f32x4*)y1 = (f32x4){bflo(w1[j].x), bfhi(w1[j].x), bflo(w1[j].y), bfhi(w1[j].y)} * rs1 * gv[j][0]; *(GAS f32x4*)(y1 + 4) = (f32x4){bflo(w1[j].z), bfhi(w1[j].z), bflo(w1[j].w), bfhi(w1[j].w)} * rs1 * gv[j][1]; }
    }
}
struct Args { const float* in[24]; float* out; unsigned char* ws; int ph_lo, ph_hi; };
constexpr int N_PHASES = 14;
__global__ void __launch_bounds__(NWAVES * 64, 2) mega_fwd(Args  ) {
    extern __shared__ __attribute__((aligned(16))) unsigned char lds[];
    Frame F;
    F.lds = (LAS unsigned char*)lds; F.MISC = (volatile LAS unsigned*)(F.lds + MISC_OFF);
    { const int tid0 = threadIdx.x; F.wave = __builtin_amdgcn_readfirstlane(tid0 >> 6);
      for (int u = tid0; u < (LDS_BYTES - LDSCTL_OFF) / 4; u += NWAVES * 64) ((LAS unsigned*)(F.lds + LDSCTL_OFF))[u] = 0u; }
    F.G = gridDim.x; { const int bx = blockIdx.x; F.vcu = (F.G % 8 == 0) ? (bx % 8) * (F.G / 8) + bx / 8 : bx; }
    __syncthreads();
    const int lo = karg<int>(208), hi = karg<int>(212);
    const bool use_bar = (hi - lo) > 1;
    XcdBarrier bar; bar.bar = (unsigned*)(KWS() + WS_CTL) + CW_BAR; bar.x = 0; bar.st = nullptr; bar.G = 0; bar.wave = F.wave;
    if (use_bar) bar = xcd_barrier_post((unsigned*)(KWS() + WS_CTL) + CW_BAR, F.MISC + 8, F.wave, (unsigned)F.G);
#define IN(k) (lo <= (k) && (k) < hi)
#define SEAM(k) do { if (IN(k) && IN((k) + 1)) { xcd_barrier(bar); if (PROBE_BAR2) xcd_barrier(bar); } } while (0)
#define WSP(T, off) ((T)(KWS() + (off)))
#ifndef PG_ALIGN
#define PG_ALIGN true
#endif
#ifndef PROBE_BAR2
#define PROBE_BAR2 0
#endif
#ifndef PROBE_MASK
#define PROBE_MASK 0
#endif
#ifndef PG_SP2
#define PG_SP2 true
#endif
#ifndef STAGGER
#define STAGGER 1
#endif
#ifndef PROBE_SKINNY
#define PROBE_SKINNY 0
#endif
#ifndef STAG_KEY
#define STAG_KEY(v) ((v) & 3)
#endif

    const int bx = (int)blockIdx.x;
#define GEMM_BIG(OP, Aoff, lda_, ashift, aelems, Boff, ldb_, K_, N_) \
        { pg8::Gemm g{WSP(const bf16*, Aoff), WSP(const bf16*, Boff), K_, lda_, ldb_, ashift, (aelems) * 32};        pg8::StaticOrder S; S.init(MP, N_, F.G, bx, WGM_OF(N_, K_)); Epi8<OP> E{F.lds}; \
          pg8::gemm_phase<Epi8<OP>, pg8::StaticOrder, (OP::HAS_SS || PG_ALIGN), PG_SP2>(F.lds, F.wave, g, S, E); }
#define SK_C64(OP, N_) ((N_) == D && OP::HAS_SS)
#define GEMM_SKINNY(OP, Aoff, lda_, ashift, aelems, Boff, ldb_, K_, N_, kb_, ke_) \
        { if (PROBE_SK_RES && OP::HAS_SS && (PROBE_SK_RES == 1 || (PROBE_SK_RES == 2) == ((K_) > 1024))) { F.dry = 1; skinny_phase<OP, SK_C64(OP, N_)>(F, WSP(const bf16*, Aoff), lda_, ashift, aelems, WSP(const bf16*, Boff), ldb_, K_, (N_) / 256, kb_, ke_); F.dry = 0; } \
          skinny_phase<OP, SK_C64(OP, N_)>(F, WSP(const bf16*, Aoff), lda_, ashift, aelems, WSP(const bf16*, Boff), ldb_, K_, (N_) / 256, kb_, ke_); \
          if (PROBE_SKINNY && !OP::HAS_SS) skinny_phase<OP, SK_C64(OP, N_)>(F, WSP(const bf16*, Aoff), lda_, ashift, aelems, WSP(const bf16*, Boff), ldb_, K_, (N_) / 256, kb_, ke_); }
#define GEMM_PHASE(OP, Aoff, lda_, ashift, aelems, Boff, ldb_, K_, N_) do { \
        const int nsk_ = ((N_) / 256) * (SK_C64(OP, N_) ? 64 : 32), nw_ = F.vcu < nsk_ ? (nsk_ - F.vcu + F.G - 1) / F.G : 0, nf_ = STAGGER ? (nw_ * STAG_KEY(F.vcu) + 1) / 3 : 0; \
        GEMM_SKINNY(OP, Aoff, lda_, ashift, aelems, Boff, ldb_, K_, N_, 0, nf_) __syncthreads(); \
        GEMM_BIG(OP, Aoff, lda_, ashift, aelems, Boff, ldb_, K_, N_) \
        GEMM_SKINNY(OP, Aoff, lda_, ashift, aelems, Boff, ldb_, K_, N_, nf_, nw_) } while (0)
#define RUNPH(k, stmt) do { if (IN(k)) { stmt; if ((PROBE_MASK >> (k)) & 1) { __syncthreads(); stmt; } } SEAM(k); } while (0)
    RUNPH(0, p0_prologue(F));
    RUNPH(1, GEMM_PHASE(OpQKV, WS_XB, D, 0, 0, WS_WQKV, D, D, NQKV));
    RUNPH(2, attn_phase(F));
    RUNPH(3, GEMM_PHASE(OpRes, WS_O, D, 0, 0, WS_WO, D, D, D));
    RUNPH(4, GEMM_PHASE(OpSwiglu, WS_XB, D, 0, 0, WS_WFI0, D, D, 2 * DFF));
    RUNPH(5, GEMM_PHASE(OpRes, WS_H, DFF, 0, 0, WS_WFO0, DFF, DFF, D));
    RUNPH(6, GEMM_PHASE(OpRecIn, WS_XB, D, 0, 0, WS_WRI, D, D, 2048));
    RUNPH(7, { conv_fixup(F, bx); GEMM_PHASE(OpGates, WS_XC, D, 1, 256, WS_WG, 256, 256, 2048); });
    RUNPH(8, scan1_phase(F));
    RUNPH(9, scan2_phase(F));
    RUNPH(10, GEMM_PHASE(OpRes, WS_XBC, D, 0, 0, WS_WRO, D, D, D));
    RUNPH(11, GEMM_PHASE(OpSwiglu, WS_XB, D, 0, 0, WS_WFI1, D, D, 2 * DFF));
    RUNPH(12, GEMM_PHASE(OpRes, WS_H, DFF, 0, 0, WS_WFO1, DFF, DFF, D));
    if (IN(13)) { final_norm_phase(F); if ((PROBE_MASK >> 13) & 1) final_norm_phase(F); }
#undef IN
#undef SEAM
#undef WSP
}

#ifndef MK_ONE_LAUNCH
#define MK_ONE_LAUNCH 1
#endif
extern "C" void kernel_launch(void* const* d_in, const int* in_sizes, int n_in, void* d_out, int out_size, void* d_ws, size_t ws_size, hipStream_t stream) {
    static int grid = 0;
    if (grid == 0) {
        if (n_in != 24 || ws_size < WS_END) { fprintf(stderr, "kernel_launch: unexpected n_in %d / ws %zu\n", n_in, ws_size); grid = -1; return; }
        int dev = 0, cus = 0, per_cu = 0;
        if (hipGetDevice(&dev) != hipSuccess || hipDeviceGetAttribute(&cus, hipDeviceAttributeMultiprocessorCount, dev) != hipSuccess) { grid = -1; return; }
        if (hipFuncSetAttribute((const void*)mega_fwd, hipFuncAttributeMaxDynamicSharedMemorySize, LDS_BYTES) != hipSuccess) { fprintf(stderr, "kernel_launch: hipFuncSetAttribute failed\n"); grid = -1; return; }
        if (hipOccupancyMaxActiveBlocksPerMultiprocessor(&per_cu, (const void*)mega_fwd, NWAVES * 64, LDS_BYTES) != hipSuccess || per_cu < 1) { fprintf(stderr, "kernel_launch: occupancy query says %d\n", per_cu); (void)hipGetLastError(); grid = -1; return; }
        grid = cus;
    }
    if (grid < 0) return;
    (void)hipMemsetAsync((char*)d_ws + WS_CTL, 0, CTL_ZERO_BYTES, stream);
    Args a{};
    for (int i = 0; i < 24; ++i) a.in[i] = (const float*)d_in[i];
    a.out = (float*)d_out; a.ws = (unsigned char*)d_ws;
#if MK_ONE_LAUNCH
    a.ph_lo = 0; a.ph_hi = N_PHASES;
    hipLaunchKernelGGL(mega_fwd, dim3(grid), dim3(NWAVES * 64), LDS_BYTES, stream, a);
#else
    for (int p = 0; p < N_PHASES; ++p) { a.ph_lo = p; a.ph_hi = p + 1; hipLaunchKernelGGL(mega_fwd, dim3(grid), dim3(NWAVES * 64), LDS_BYTES, stream, a); }
#endif
}
```

```cpp
#include <hip/hip_runtime.h>
#include <cstdio>
#include <cstdint>
namespace pg8 {
#define PG8_LAS __attribute__((address_space(3)))
typedef unsigned short bf16_t;
typedef short bf16x8 __attribute__((ext_vector_type(8)));
typedef float f32x4 __attribute__((ext_vector_type(4)));
typedef unsigned u32x4 __attribute__((ext_vector_type(4)));
constexpr int BM = 256, BK = 64, HALF = 128, HTB = HALF * BK * 2  , STAGE_BYTES = 8 * HTB, NXCD = 8;

__host__ __device__ __forceinline__ int lds_byte(int r, int c) { const int st = (r >> 4) * 2 + (c >> 5), rr = r & 15, cc = c & 31, ob = rr * 64 + cc * 2; return st * 1024 + (ob ^ (((ob >> 9) & 1) << 5)); }
__host__ __device__ __forceinline__ void stage_rc(int b, int& R, int& C) { const int st = b / 1024, sb = b % 1024, swz = sb ^ (((sb >> 9) & 1) << 5); R = (st >> 1) * 16 + swz / 64; C = (st & 1) * 32 + (swz % 64) / 2; }
__host__ __device__ __forceinline__ int perm32(int rho) { const int n = rho >> 4, i = rho & 15; return 8 * (i >> 2) + 4 * n + (i & 3); }

struct Unit { int pm, pn; };
struct Gemm { const bf16_t* A; const bf16_t* Bt; int K, lda, ldb, acol_shift, acol_bytes;
    __device__ __forceinline__ const char* abase(const Unit& u) const { return (const char*)A + (size_t)u.pm * 512 * lda + (size_t)((u.pn >> acol_shift) * acol_bytes); }
    __device__ __forceinline__ const char* bbase(const Unit& u) const { return (const char*)Bt + (size_t)u.pn * 512 * ldb; } };

struct StaticOrder {
    int nM, nN, nwg, G, c, WGM;
    __host__ __device__ void init(int M, int N, int G_, int c_, int wgm = 16) { nM = M / BM; nN = N / BM; nwg = nM * nN; G = G_; c = c_; WGM = wgm; }
    __host__ __device__ bool next(int i, Unit& u) const {
        const long L = (long)i * G + c; if (L >= nwg) return false;
        int wgid = (int)L; { const int q = nwg / NXCD, r = nwg % NXCD, xcd = wgid % NXCD, off = wgid / NXCD; wgid = (xcd < r ? xcd * (q + 1) : r * (q + 1) + (xcd - r) * q) + off; }
        const int nig = WGM * nN, gid = wgid / nig, fm = gid * WGM, gsz = (nM - fm) < WGM ? (nM - fm) : WGM;
        u.pm = fm + ((wgid % nig) % gsz); u.pn = (wgid % nig) / gsz; return true;
    }
    __device__ __forceinline__ void a_ready(const Unit&) const {}
    __device__ __forceinline__ void done(const Unit&) const {}
};

#ifndef PG_ZEROC
#define PG_ZEROC 1
#endif
template <class Epi, class Sched, bool ALIGN_EPI = false, bool SP2 = false>
__device__ __forceinline__ void gemm_phase(PG8_LAS unsigned char* lds, const int wid, const Gemm g, const Sched& S, const Epi& E) {
    unsigned z_ = 0u; asm volatile("" : "+v"(z_));
    const int lane = (int)__builtin_amdgcn_mbcnt_hi(~0u, __builtin_amdgcn_mbcnt_lo(~0u, z_)), tid = wid * 64 + lane, wr = wid >> 2, wc = wid & 3, fr = lane & 15, fq = lane >> 4;
#if defined(PROBE_K2) && PROBE_K2
    const int K = g.K, ntr = K / BK, nt = 2 * ntr;
#define PG8_KT(t_) ((t_) % ntr)
#else
    const int K = g.K, nt = K / BK;
#define PG8_KT(t_) (t_)
#endif
    unsigned voffA[2], voffB[2];
#pragma unroll
    for (int i = 0; i < 2; ++i) { int R, C; stage_rc(tid * 16 + i * 8192, R, C); const int Rb = Epi::PERM ? ((R & ~31) + perm32(R & 31)) : R;
        voffA[i] = (unsigned)(((R >> 4) * (g.lda >> 5) + (C >> 5)) * 1024 + (R & 15) * 64 + (C & 31) * 2); voffB[i] = (unsigned)(((Rb >> 4) * (g.ldb >> 5) + (C >> 5)) * 1024 + (Rb & 15) * 64 + (C & 31) * 2); }
    const size_t kstep = 2048, kstepB = 2048;
    const size_t hstepA = (size_t)HALF * g.lda * 2, hstepB = (size_t)HALF * g.ldb * 2;

    const unsigned ldsw = (unsigned)wid * 1024u;
    const int aoff = lds_byte(wr * 64 + fr, fq * 8), boff = lds_byte(wc * 32 + fr, fq * 8);
#define PG8_SA(b, h) (((b) * 2 + (h)) * HTB)
#define PG8_SB(b, h) ((4 + (b) * 2 + (h)) * HTB)
#define PG8_STAGE(bufoff, gbase, voff) do { _Pragma("unroll") for (int _i = 0; _i < 2; ++_i) \
        __builtin_amdgcn_global_load_lds((const unsigned*)((const char*)(gbase) + (voff)[_i]), (PG8_LAS unsigned*)(lds + (bufoff) + ldsw + _i * 8192), 16, 0, 0); } while (0)
#define PG8_LDA(dst, b, h) do { _Pragma("unroll") for (int m = 0; m < 4; ++m) _Pragma("unroll") for (int k = 0; k < 2; ++k) dst[m][k] = *(const PG8_LAS bf16x8*)(lds + PG8_SA(b, h) + aoff + m * 2048 + k * 1024); } while (0)
#define PG8_LDB(dst, b, h) do { _Pragma("unroll") for (int n = 0; n < 2; ++n) _Pragma("unroll") for (int k = 0; k < 2; ++k) dst[n][k] = *(const PG8_LAS bf16x8*)(lds + PG8_SB(b, h) + boff + n * 2048 + k * 1024); } while (0)
#define PG8_MMA(ai, bj, At, Bt) do { PG8_PRIO(1); _Pragma("unroll") for (int m = 0; m < 4; ++m) _Pragma("unroll") for (int n = 0; n < 2; ++n) _Pragma("unroll") for (int k = 0; k < 2; ++k) \
        { acc[ai][bj][m][n] = __builtin_amdgcn_mfma_f32_16x16x32_bf16(Bt[n][k], At[m][k], acc[ai][bj][m][n], 0, 0, 0); PG8_MMA_AGAIN(ai, bj, m, n, k, At, Bt) } PG8_PRIO(0); } while (0)
#define PG8_MMAZ(ai, bj, At, Bt) do { PG8_PRIO(1); _Pragma("unroll") for (int m = 0; m < 4; ++m) _Pragma("unroll") for (int n = 0; n < 2; ++n) \
        { asm("v_mfma_f32_16x16x32_bf16 %0, %1, %2, 0" : "=&v"(acc[ai][bj][m][n]) : "v"(Bt[n][0]), "v"(At[m][0])); \
          acc[ai][bj][m][n] = __builtin_amdgcn_mfma_f32_16x16x32_bf16(Bt[n][1], At[m][1], acc[ai][bj][m][n], 0, 0, 0); } PG8_PRIO(0); } while (0)
#if defined(PROBE_MMA2) && PROBE_MMA2
#define PG8_MMA_AGAIN(ai, bj, m, n, k, At, Bt) acc[ai][bj][m][n] = __builtin_amdgcn_mfma_f32_16x16x32_bf16(Bt[n][k], At[m][k], acc[ai][bj][m][n], 0, 0, 0);
#else
#define PG8_MMA_AGAIN(ai, bj, m, n, k, At, Bt)
#endif
#if defined(PG_STATIC_PRIO) && PG_STATIC_PRIO
#define PG8_PRIO(x)
#else
#define PG8_PRIO(x) __builtin_amdgcn_s_setprio(x)
#endif
#define PG8_WAIT_V(n) asm volatile("s_waitcnt vmcnt(" #n ")" ::: "memory")
#define PG8_WAIT_L(n) asm volatile("s_waitcnt lgkmcnt(" #n ")" ::: "memory")
#define PG8_BAR __builtin_amdgcn_s_barrier()
#define PG8_SCHED __builtin_amdgcn_sched_barrier(0)
#define PG8_SP2SEQ(PG8_MA_, PG8_MB_) \
            PG8_LDB(B0, 0, 0); PG8_LDB(B1, 0, 1); PG8_SCHED; PG8_LDA(At, 0, 0); PG8_STAGE(PG8_SA(1, 1), a1 + hstepA, voffA); \
            PG8_WAIT_V(8); PG8_WAIT_L(0); PG8_BAR; PG8_MA_(0, 0, At, B0); PG8_MA_(0, 1, At, B1); PG8_BAR; PG8_SCHED; \
            PG8_LDA(At, 0, 1); PG8_STAGE(PG8_SB(0, 0), b2, voffB); PG8_STAGE(PG8_SB(0, 1), b2 + hstepB, voffB); PG8_STAGE(PG8_SA(0, 0), a2, voffA); \
            PG8_WAIT_V(8); PG8_WAIT_L(0); PG8_BAR; PG8_MA_(1, 0, At, B0); PG8_MA_(1, 1, At, B1); PG8_BAR; PG8_SCHED; \
            PG8_LDB(B0, 1, 0); PG8_LDB(B1, 1, 1); PG8_SCHED; PG8_LDA(At, 1, 0); PG8_STAGE(PG8_SA(0, 1), a2 + hstepA, voffA); \
            PG8_WAIT_V(8); PG8_WAIT_L(0); PG8_BAR; PG8_MB_(0, 0, At, B0); PG8_MB_(0, 1, At, B1); PG8_BAR; PG8_SCHED; \
            PG8_LDA(At, 1, 1); PG8_STAGE(PG8_SB(1, 0), b3, voffB); PG8_STAGE(PG8_SB(1, 1), b3 + hstepB, voffB); PG8_STAGE(PG8_SA(1, 0), a3, voffA); \
            PG8_WAIT_V(8); PG8_WAIT_L(0); PG8_BAR; PG8_MB_(1, 0, At, B0); PG8_MB_(1, 1, At, B1); PG8_BAR; PG8_SCHED;
    Unit cur, nxt; int ui = 0;
    if (!S.next(0, cur)) return;
#if defined(PG_STATIC_PRIO) && PG_STATIC_PRIO
    if (wr == (PG_STATIC_PRIO - 1)) __builtin_amdgcn_s_setprio(1);
#endif
    f32x4 acc[2][2][4][2];
    if constexpr (!SP2 || !PG_ZEROC) {
#pragma unroll
    for (int a = 0; a < 2; ++a)
#pragma unroll
        for (int b = 0; b < 2; ++b)
#pragma unroll
            for (int m = 0; m < 4; ++m)
#pragma unroll
                for (int n = 0; n < 2; ++n) acc[a][b][m][n] = (f32x4){0.f, 0.f, 0.f, 0.f};
    }
    bf16x8 At[4][2], B0[2][2], B1[2][2];
    const char* cA = g.abase(cur); const char* cB = g.bbase(cur);
    S.a_ready(cur);
    if constexpr (SP2) {
        PG8_STAGE(PG8_SB(0, 0), cB, voffB); PG8_STAGE(PG8_SB(0, 1), cB + hstepB, voffB); PG8_STAGE(PG8_SA(0, 0), cA, voffA); PG8_STAGE(PG8_SA(0, 1), cA + hstepA, voffA);
        E.first_unit(cur, wid);
        if (wr == 1) PG8_BAR;
        PG8_WAIT_V(2); PG8_BAR;
        PG8_STAGE(PG8_SB(1, 0), cB + kstepB, voffB); PG8_STAGE(PG8_SA(1, 0), cA + kstep, voffA); PG8_STAGE(PG8_SB(1, 1), cB + hstepB + kstepB, voffB);
        PG8_WAIT_V(6); PG8_BAR;
    } else {
        PG8_STAGE(PG8_SB(0, 0), cB, voffB); PG8_STAGE(PG8_SA(0, 0), cA, voffA); PG8_STAGE(PG8_SB(0, 1), cB + hstepB, voffB); PG8_STAGE(PG8_SA(0, 1), cA + hstepA, voffA);
        E.first_unit(cur, wid);
        if (wr == 1) PG8_BAR;
        PG8_WAIT_V(4); PG8_BAR;
        PG8_STAGE(PG8_SB(1, 0), cB + kstepB, voffB); PG8_STAGE(PG8_SA(1, 0), cA + kstep, voffA); PG8_STAGE(PG8_SB(1, 1), cB + hstepB + kstepB, voffB);
        PG8_WAIT_V(6); PG8_BAR;
    }
    for (;;) {
        const bool has_next = S.next(ui + 1, nxt);
        const char* nA = has_next ? g.abase(nxt) : cA; const char* nB = has_next ? g.bbase(nxt) : cB;
#define PG8_PRE(t) \
            const bool last = ((t) == nt - 2); \
            const char* a1 = cA + (size_t)PG8_KT((t) + 1) * kstep;                                             \
            const char* a2 = last ? nA : cA + (size_t)PG8_KT((t) + 2) * kstep; const char* b2 = last ? nB : cB + (size_t)PG8_KT((t) + 2) * kstepB;     \
            const char* a3 = a2 + kstep; const char* b3 = b2 + kstepB;                                \
            if (last && has_next) S.a_ready(nxt);
        if constexpr (SP2 && PG_ZEROC) { PG8_PRE(0) PG8_SP2SEQ(PG8_MMAZ, PG8_MMA) }
        for (int t = (SP2 && PG_ZEROC) ? 2 : 0; t < nt; t += 2) {
            PG8_PRE(t)
            if constexpr (SP2) {
                PG8_SP2SEQ(PG8_MMA, PG8_MMA)
            } else {
            PG8_LDB(B0, 0, 0); PG8_SCHED; PG8_LDA(At, 0, 0); PG8_STAGE(PG8_SA(1, 1), a1 + hstepA, voffA);
            PG8_WAIT_L(8); PG8_BAR; PG8_WAIT_L(0); PG8_MMA(0, 0, At, B0); PG8_BAR; PG8_SCHED;
            PG8_LDB(B1, 0, 1); PG8_STAGE(PG8_SB(0, 0), b2, voffB);
            PG8_BAR; PG8_WAIT_L(0); PG8_MMA(0, 1, At, B1); PG8_BAR;
            PG8_LDA(At, 0, 1); PG8_STAGE(PG8_SA(0, 0), a2, voffA);
            PG8_BAR; PG8_WAIT_L(0); PG8_MMA(1, 0, At, B0); PG8_BAR; PG8_SCHED;
            PG8_STAGE(PG8_SB(0, 1), b2 + hstepB, voffB);
            PG8_WAIT_V(6); PG8_BAR; PG8_MMA(1, 1, At, B1); PG8_BAR;
            PG8_LDB(B0, 1, 0); PG8_SCHED; PG8_LDA(At, 1, 0); PG8_STAGE(PG8_SA(0, 1), a2 + hstepA, voffA);
            PG8_WAIT_L(8); PG8_BAR; PG8_WAIT_L(0); PG8_MMA(0, 0, At, B0); PG8_BAR; PG8_SCHED;
            PG8_LDB(B1, 1, 1); PG8_STAGE(PG8_SB(1, 0), b3, voffB);
            PG8_BAR; PG8_WAIT_L(0); PG8_MMA(0, 1, At, B1); PG8_BAR;
            PG8_LDA(At, 1, 1); PG8_STAGE(PG8_SA(1, 0), a3, voffA);
            PG8_BAR; PG8_WAIT_L(0); PG8_MMA(1, 0, At, B0); PG8_BAR; PG8_SCHED;
            PG8_STAGE(PG8_SB(1, 1), b3 + hstepB, voffB);
            PG8_WAIT_V(6); PG8_BAR; PG8_MMA(1, 1, At, B1); PG8_BAR;
            }
        }
        if constexpr (ALIGN_EPI) { if (wr == 0) PG8_BAR; }
        if constexpr (!Epi::AFTER_DRAIN) { E(acc, cur, nxt, has_next, ui, wr, wc, fr, fq);
#if defined(PROBE_EPI2) && PROBE_EPI2
            if constexpr (Epi::IDEMP) E(acc, cur, nxt, has_next, ui, wr, wc, fr, fq);
#endif
            S.done(cur); }
        if (!has_next) break;
        if constexpr (!SP2 || !PG_ZEROC) {
#pragma unroll
        for (int a = 0; a < 2; ++a)
#pragma unroll
            for (int b = 0; b < 2; ++b)
#pragma unroll
                for (int m = 0; m < 4; ++m)
#pragma unroll
                    for (int n = 0; n < 2; ++n) acc[a][b][m][n] = (f32x4){0.f, 0.f, 0.f, 0.f};
        }
        cur = nxt; cA = nA; cB = nB; ++ui;
        if constexpr (ALIGN_EPI) { if (wr == 1) PG8_BAR; }
    }
#if defined(PG_STATIC_PRIO) && PG_STATIC_PRIO
    __builtin_amdgcn_s_setprio(0);
#endif
    PG8_WAIT_V(0);
    if constexpr (!ALIGN_EPI) { if (wr == 0) PG8_BAR; }
    PG8_BAR;
    if constexpr (Epi::AFTER_DRAIN) { E.fused(acc, cur, wr, wc, fr, fq, lds, wid, lane); S.done(cur); }
#undef PG8_KT
#undef PG8_SA
#undef PG8_SB
#undef PG8_STAGE
#undef PG8_LDA
#undef PG8_LDB
#undef PG8_MMA
#undef PG8_MMAZ
#undef PG8_PRE
#undef PG8_SP2SEQ
#undef PG8_PRIO
#undef PG8_WAIT_V
#undef PG8_WAIT_L
#undef PG8_BAR
#undef PG8_SCHED
}
}

constexpr int D = 1024, BATCH = 4, SEQ = 8192, DECB = 128, DECT = 4;
constexpr int MP = BATCH * SEQ, MS = DECB * DECT, M = MP + MS;
constexpr int NH = 16, NKV = 4, HD = 64, DFF = 2816, NQKV = 1536;
constexpr float EPS = 1e-6f, LOG2E = 1.4426950408889634f, C2 = 0.125f * LOG2E;
constexpr size_t OFF_Y = 0, OFF_NK_P = 34078720, OFF_NV_P = 34209792, OFF_NK_S = 34340864, OFF_NV_S = 38535168,
                 OFF_NC_P = 42729472, OFF_NH_P = 42741760, OFF_NC_S = 42745856, OFF_NH_S = 43139072;
constexpr size_t MiB = 1u << 20;
constexpr size_t WS_CTL = 0, CTL_ZERO_BYTES = 32768;
constexpr size_t WS_WQKV = 2 * MiB, WS_WO = 5 * MiB, WS_WFI0 = 7 * MiB, WS_WFO0 = 18 * MiB, WS_WRI = 24 * MiB, WS_WG = 28 * MiB, WS_WRO = 29 * MiB, WS_WFI1 = 31 * MiB, WS_WFO1 = 42 * MiB;
constexpr size_t WS_SSS = 48 * MiB + (size_t)33280 * 32;
constexpr size_t WS_SS = 48 * MiB;
constexpr size_t WS_SLA = 51 * MiB, WS_HT = 52 * MiB;
constexpr size_t WS_XB = 56 * MiB;
constexpr size_t WS_R = 128 * MiB;
constexpr size_t WS_Q = WS_R, WS_K = WS_R + 65 * MiB, WS_V = WS_R + 82 * MiB, WS_O = WS_R + 99 * MiB;
constexpr size_t WS_H = WS_R;
constexpr size_t WS_GG = WS_R, WS_XBC = WS_R + 65 * MiB, WS_XC = WS_R + 130 * MiB, WS_LA = WS_R + 195 * MiB, WS_BB = WS_R + 260 * MiB;
constexpr size_t WS_SUBS = WS_R + 326 * MiB, WS_SUBH = WS_R + 330 * MiB;
constexpr size_t WS_END = WS_R + 334 * MiB;
static_assert(WS_END <= 512 * MiB, "ws map");
constexpr int CW_TMO = 0, CW_BAR = 4096;
constexpr int RING_BYTES = 131072, LDSCTL_OFF = RING_BYTES, MISC_OFF = LDSCTL_OFF + 320, LDS_BYTES = 147456;
constexpr int NWAVES = 8;
#ifndef WGM_FI
#define WGM_FI 8
#endif
#ifndef WGM_FO
#define WGM_FO 8
#endif
#ifndef WGM_OT
#define WGM_OT 16
#endif
#define WGM_OF(N_, K_) ((N_) == 2 * DFF ? WGM_FI : ((K_) == DFF ? WGM_FO : WGM_OT))

#define GAS __attribute__((address_space(1)))
#define LAS __attribute__((address_space(3)))
typedef unsigned short bf16;
typedef unsigned v4u __attribute__((ext_vector_type(4)));
typedef unsigned v2u __attribute__((ext_vector_type(2)));
typedef float f32x4 __attribute__((ext_vector_type(4)));
typedef float f32x2 __attribute__((ext_vector_type(2)));
typedef float f32x16 __attribute__((ext_vector_type(16)));
typedef short bf16x8 __attribute__((ext_vector_type(8)));
typedef short s16x4 __attribute__((ext_vector_type(4)));
typedef _Float16 h16x2 __attribute__((ext_vector_type(2)));
typedef _Float16 h16x8 __attribute__((ext_vector_type(8)));
typedef GAS unsigned gu32;
#define RLX_AGENT __ATOMIC_RELAXED, __HIP_MEMORY_SCOPE_AGENT
#define LDS_WAIT() asm volatile("s_waitcnt lgkmcnt(0)" ::: "memory")
#define VM_WAIT() asm volatile("s_waitcnt vmcnt(0)" ::: "memory")
__device__ __forceinline__ unsigned f2bf(float f) { unsigned u = __builtin_bit_cast(unsigned, f); return (u + 0x7fffu + ((u >> 16) & 1u)) >> 16; }
typedef float f32x2_t_ __attribute__((ext_vector_type(2))); typedef __bf16 bf16x2_t_ __attribute__((ext_vector_type(2)));
__device__ __forceinline__ unsigned pk2(float lo, float hi) { f32x2_t_ v = {lo, hi}; bf16x2_t_ b = __builtin_convertvector(v, bf16x2_t_); return __builtin_bit_cast(unsigned, b); }
__device__ __forceinline__ v4u pack8(f32x4 a, f32x4 b) { v4u w; w.x = pk2(a[0], a[1]); w.y = pk2(a[2], a[3]); w.z = pk2(b[0], b[1]); w.w = pk2(b[2], b[3]); return w; }
__device__ __forceinline__ float bf2f(unsigned short b) { return __builtin_bit_cast(float, (unsigned)b << 16); }
__device__ __forceinline__ float bflo(unsigned w) { return __builtin_bit_cast(float, w << 16); }
__device__ __forceinline__ float bfhi(unsigned w) { return __builtin_bit_cast(float, w & 0xffff0000u); }
__device__ __forceinline__ float ex2(float x) { return __builtin_amdgcn_exp2f(x); }
__device__ __forceinline__ float rcpf_(float x) { return __builtin_amdgcn_rcpf(x); }
__device__ __forceinline__ float wave_sum(float v) {
#pragma unroll
    for (int o = 1; o < 64; o <<= 1) v += __shfl_xor(v, o);
    return v;
}
__device__ __forceinline__ float wave_max(float v) {
#pragma unroll
    for (int o = 1; o < 64; o <<= 1) v = fmaxf(v, __shfl_xor(v, o));
    return v;
}

__device__ __forceinline__ unsigned blk_off(int row, int col, int kdim) { return ((unsigned)(row >> 4) * (unsigned)(kdim >> 5) + (unsigned)(col >> 5)) * 512u + (unsigned)((row & 15) * 32 + (col & 31)); }
__device__ __forceinline__ int xb_lane_id() { unsigned z = 0u; asm volatile("" : "+v"(z)); return (int)__builtin_amdgcn_mbcnt_hi(~0u, __builtin_amdgcn_mbcnt_lo(~0u, z)); }
#define XB_T0(b) ((b).wave == 0 && xb_lane_id() == 0)
#define XB_TMO      128
#define XB_XCNT(j)  (256  + 64 * (j))
#define XB_XSUB(j)  (1280 + 64 * (j))
#define XB_XGEN(j)  (2304 + 64 * (j))
#define XB_TOP      3328
#define XB_TOPGEN   3392
#define XCD_BAR_WORDS 3456
#define XB_SPIN_CAP (1u << 18)

__device__ __forceinline__ unsigned xb_ld(unsigned* p)              { return __hip_atomic_load(p, __ATOMIC_RELAXED, __HIP_MEMORY_SCOPE_AGENT); }
__device__ __forceinline__ unsigned xb_add(unsigned* p, unsigned v) { return __hip_atomic_fetch_add(p, v, __ATOMIC_RELAXED, __HIP_MEMORY_SCOPE_AGENT); }
__device__ __forceinline__ unsigned xb_xcc_id() { return (unsigned)__builtin_amdgcn_s_getreg((3 << 11) | 20) & 0xFu; }
#define XB_SPIN(cond, bar) do { unsigned _sp = 0; while (cond) { __builtin_amdgcn_s_sleep(1); \
    if ((++_sp & 255u) == 0u) { if (xb_ld(&(bar)[XB_TMO])) break; if (_sp > XB_SPIN_CAP) { atomicAdd(&(bar)[XB_TMO], 1u); break; } } } } while (0)

struct XcdBarrier {
    unsigned* bar; unsigned x; unsigned G; int wave;
    volatile LAS unsigned* st;
};

__device__ __forceinline__ XcdBarrier xcd_barrier_post(unsigned* bar, volatile LAS unsigned* st, int wave, unsigned G) {
    XcdBarrier b; b.bar = bar; b.x = xb_xcc_id(); b.st = st; b.G = G; b.wave = wave;
    if (XB_T0(b)) (void)xb_add(&bar[XB_XCNT(b.x)], 1u);
    return b;
}
__device__ __forceinline__ void xcd_barrier_complete(unsigned* bar, unsigned x, const unsigned G, unsigned& nloc, unsigned& nx) {
    unsigned sum, cnt, mine, sp = 0u;
    for (;;) {
        sum = 0u; cnt = 0u; mine = 0u;
#pragma unroll
        for (unsigned j = 0; j < 16; ++j) { const unsigned c = xb_ld(&bar[XB_XCNT(j)]); sum += c; cnt += (c > 0u) ? 1u : 0u; mine = (j == x) ? c : mine; }
        if (sum == G) break;
        __builtin_amdgcn_s_sleep(1);
        if ((++sp & 255u) == 0u) { if (xb_ld(&bar[XB_TMO])) break; if (sp > XB_SPIN_CAP) { atomicAdd(&bar[XB_TMO], 1u); break; } }
    }
    nloc = mine > 0u ? mine : 1u; nx = cnt > 0u ? cnt : 1u;
}

__device__ __forceinline__ void xcd_barrier(const XcdBarrier& b) {
    asm volatile("s_waitcnt vmcnt(0)" ::: "memory");
    __syncthreads();
    if (XB_T0(b)) {
        unsigned* bar = b.bar;
        __builtin_amdgcn_s_waitcnt(0);
        unsigned nloc = b.st[0], nx = b.st[1];
        if (nloc == 0u) { xcd_barrier_complete(bar, b.x, b.G, nloc, nx); b.st[0] = nloc; b.st[1] = nx; }
        const unsigned old = xb_add(&bar[XB_XSUB(b.x)], 1u);
        const unsigned gen = old / nloc;
        if (old + 1u == (gen + 1u) * nloc) {
            __builtin_amdgcn_fence(__ATOMIC_RELEASE, "agent");
            asm volatile("s_waitcnt vmcnt(0)" ::: "memory");
            const unsigned og = xb_add(&bar[XB_TOP], 1u);
            const unsigned tg = og / nx;
            if (og + 1u != (tg + 1u) * nx) XB_SPIN(xb_ld(&bar[XB_TOP]) < (tg + 1u) * nx, bar);
            __builtin_amdgcn_fence(__ATOMIC_ACQUIRE, "agent");
            asm volatile("s_waitcnt vmcnt(0)" ::: "memory");
        } else {
            XB_SPIN(xb_ld(&bar[XB_TOP]) < (gen + 1u) * nx, bar);
            __builtin_amdgcn_fence(__ATOMIC_ACQUIRE, "agent");
            asm volatile("s_waitcnt vmcnt(0)" ::: "memory");
        }
    }
    __syncthreads();
}

__device__ __forceinline__ void xcd_arrive(const XcdBarrier& b) {
    asm volatile("s_waitcnt vmcnt(0)" ::: "memory");
    __syncthreads();
    if (XB_T0(b)) {
        unsigned* bar = b.bar;
        __builtin_amdgcn_s_waitcnt(0);
        unsigned nloc = b.st[0], nx = b.st[1];
        if (nloc == 0u) { xcd_barrier_complete(bar, b.x, b.G, nloc, nx); b.st[0] = nloc; b.st[1] = nx; }
        const unsigned old = xb_add(&bar[XB_XSUB(b.x)], 1u);
        const unsigned gen = old / nloc;
        if (old + 1u == (gen + 1u) * nloc) {
            __builtin_amdgcn_fence(__ATOMIC_RELEASE, "agent");
            asm volatile("s_waitcnt vmcnt(0)" ::: "memory");
            (void)xb_add(&bar[XB_TOP], 1u);
        }
        b.st[2] = gen; b.st[3] = ((old - gen * nloc) * 2u < nloc) ? 1u : 0u;
    }
}
__device__ __forceinline__ void xcd_wait(const XcdBarrier& b) {
    asm volatile("s_waitcnt vmcnt(0)" ::: "memory");
    __syncthreads();
    if (XB_T0(b)) {
        const unsigned gen = b.st[2];
        asm volatile("buffer_inv sc1" ::: "memory");
        const unsigned nx = b.st[1];
        XB_SPIN(xb_ld(&b.bar[XB_TOP]) < (gen + 1u) * nx, b.bar);
        asm volatile("s_waitcnt vmcnt(0)" ::: "memory");
    }
    __syncthreads();
}

typedef __attribute__((address_space(4))) const unsigned char* kptr_t;
template <class T> __device__ __forceinline__ T karg(int byte_off) { return *(const __attribute__((address_space(4))) T*)((kptr_t)__builtin_amdgcn_kernarg_segment_ptr() + byte_off); }
#define KIN(k) karg<const float*>(8 * (k))
#define KOUT() karg<float*>(192)
#define KWS() karg<unsigned char*>(200)
__device__ __forceinline__ int lane_id_opaque() { unsigned z = 0u; asm volatile("" : "+v"(z)); return (int)__builtin_amdgcn_mbcnt_hi(~0u, __builtin_amdgcn_mbcnt_lo(~0u, z)); }
struct Frame {
    LAS unsigned char* lds;
    volatile LAS unsigned* MISC;
    int wave, vcu, G, dry;
    int cck;
    int wk;
};

__device__ __forceinline__ int rowmap(int mode, int moff, int n) {
    if (mode == 0) return n + moff;
    if (mode == 1) return n < DFF ? 256 * (n >> 7) + (n & 127) : 256 * ((n - DFF) >> 7) + 128 + ((n - DFF) & 127);
    return moff + 256 * (n >> 7) + (n & 127);
}
__device__ __forceinline__ void tr_item(const float* W, int ldw, int N, const float* gain, bf16* WT, int ldt, int mode, int moff, LAS float* scr, int item, int lane) {
    const int nblk = N / 32, kb = item / nblk, nb = item % nblk, k0 = 64 * kb, n0 = 32 * nb;
    f32x4 v[8]; float gn[8];
#pragma unroll
    for (int i = 0; i < 8; ++i) { const int kk = 8 * i + (lane >> 3); v[i] = *(const f32x4*)(W + (size_t)(k0 + kk) * ldw + n0 + 4 * (lane & 7)); gn[i] = gain ? gain[k0 + kk] : 1.0f; }
#pragma unroll
    for (int i = 0; i < 8; ++i) { const int kk = 8 * i + (lane >> 3); LAS float* d = scr + kk * 33 + 4 * (lane & 7); d[0] = v[i].x * gn[i]; d[1] = v[i].y * gn[i]; d[2] = v[i].z * gn[i]; d[3] = v[i].w * gn[i]; }
    LDS_WAIT(); asm volatile("" ::: "memory");
    const int c = lane & 7;
#pragma unroll
    for (int j = 0; j < 4; ++j) { const int n = (lane >> 3) + 8 * j; const LAS float* s = scr + (8 * c) * 33 + n;
        v4u o; o.x = pk2(s[0 * 33], s[1 * 33]); o.y = pk2(s[2 * 33], s[3 * 33]); o.z = pk2(s[4 * 33], s[5 * 33]); o.w = pk2(s[6 * 33], s[7 * 33]);
        const int wr_ = rowmap(mode, moff, n0 + n), wk_ = k0 + 8 * c;
        *(GAS v4u*)(WT + ((size_t)(wr_ >> 4) * (ldt >> 5) + (wk_ >> 5)) * 512 + (wr_ & 15) * 32 + (wk_ & 31)) = o; }
    LDS_WAIT(); asm volatile("" ::: "memory");
}
constexpr int I_QKV = 16 * 48, I_O = 16 * 32, I_FI = 16 * 176, I_FO = 44 * 32, I_RI = 16 * 64, I_G = 4 * 8, I_RO = 16 * 32;
constexpr int IT0 = 0, IT1 = I_QKV, IT2 = IT1 + I_O + I_FI, IT3 = IT2 + I_FO + I_RI + 8 * I_G + I_RO, IT4 = IT3 + I_FI + I_FO;
__device__ __forceinline__ void tr_dispatch(unsigned char* ws, LAS float* scr, int r, int lane) {
    if (r < I_QKV) { tr_item(KIN(7), NQKV, NQKV, KIN(6), (bf16*)(ws + WS_WQKV), D, 0, 0, scr, r, lane); return; } r -= I_QKV;
    if (r < I_O) { tr_item(KIN(8), D, D, nullptr, (bf16*)(ws + WS_WO), D, 0, 0, scr, r, lane); return; } r -= I_O;
    if (r < I_FI) { tr_item(KIN(21), 2 * DFF, 2 * DFF, KIN(20), (bf16*)(ws + WS_WFI0), D, 1, 0, scr, r, lane); return; } r -= I_FI;
    if (r < I_FO) { tr_item(KIN(22), D, D, nullptr, (bf16*)(ws + WS_WFO0), DFF, 0, 0, scr, r, lane); return; } r -= I_FO;
    if (r < I_RI) { tr_item(KIN(11), 2048, 2048, KIN(10), (bf16*)(ws + WS_WRI), D, 0, 0, scr, r, lane); return; } r -= I_RI;
    if (r < 8 * I_G) { const int q = r / I_G, blk = q >> 1, ig = q & 1;
        tr_item((ig ? KIN(16) : KIN(14)) + (size_t)blk * 65536, 256, 256, nullptr, (bf16*)(ws + WS_WG), 256, 2, 512 * blk + 128 * ig, scr, r % I_G, lane); return; } r -= 8 * I_G;
    if (r < I_RO) { tr_item(KIN(19), D, D, nullptr, (bf16*)(ws + WS_WRO), D, 0, 0, scr, r, lane); return; } r -= I_RO;
    if (r < I_FI) { tr_item(KIN(21) + (size_t)D * 2 * DFF, 2 * DFF, 2 * DFF, KIN(20) + D, (bf16*)(ws + WS_WFI1), D, 1, 0, scr, r, lane); return; } r -= I_FI;
    tr_item(KIN(22) + (size_t)DFF * D, D, D, nullptr, (bf16*)(ws + WS_WFO1), DFF, 0, 0, scr, r, lane);
}
__device__ __forceinline__ int tr_count(const Frame& F, int lo, int hi) { const int gw = F.vcu * NWAVES + F.wave, NGW = F.G * NWAVES; return hi - lo > gw ? (hi - lo - gw + NGW - 1) / NGW : 0; }
__device__ __forceinline__ void tr_range(Frame& F, int lo, int kb, int ke) {
    if (kb >= ke) return;
    LAS float* scr = (LAS float*)(F.lds + F.wave * 16384);
    const int lane = lane_id_opaque();
    const int gw = F.vcu * NWAVES + F.wave, NGW = F.G * NWAVES;
    unsigned char* ws = KWS();
    for (int k = kb; k < ke; ++k) tr_dispatch(ws, scr, lo + gw + k * NGW, lane);
}
__device__ __forceinline__ void p0_prologue(Frame& F) {
    const int lane = lane_id_opaque();
    const int gw = F.vcu * NWAVES + F.wave, NGW = F.G * NWAVES;
    unsigned char* ws = KWS();
    tr_range(F, IT0, 0, tr_count(F, IT0, IT1));
    bf16* XB = (bf16*)(ws + WS_XB); float* SS = (float*)(ws + WS_SS);
    for (int m0 = 2 * gw; m0 < M; m0 += 2 * NGW) {
        const int m1 = m0 + 1;
        const float* xrow0 = m0 < MP ? KIN(0) + (size_t)m0 * D : KIN(1) + (size_t)(m0 - MP) * D;
        const float* xrow1 = m1 < MP ? KIN(0) + (size_t)m1 * D : KIN(1) + (size_t)(m1 - MP) * D;
        f32x4 v[2][2], w[2][2]; float s0 = 0.f, s1 = 0.f;
#pragma unroll
        for (int j = 0; j < 2; ++j) { const int col = 8 * lane + 512 * j;
            v[j][0] = *(const GAS f32x4*)(xrow0 + col); v[j][1] = *(const GAS f32x4*)(xrow0 + col + 4); w[j][0] = *(const GAS f32x4*)(xrow1 + col); w[j][1] = *(const GAS f32x4*)(xrow1 + col + 4); }
#pragma unroll
        for (int j = 0; j < 2; ++j)
#pragma unroll
            for (int n = 0; n < 2; ++n) { s0 += (v[j][n].x * v[j][n].x + v[j][n].y * v[j][n].y) + (v[j][n].z * v[j][n].z + v[j][n].w * v[j][n].w);
                s1 += (w[j][n].x * w[j][n].x + w[j][n].y * w[j][n].y) + (w[j][n].z * w[j][n].z + w[j][n].w * w[j][n].w); }
        s0 = wave_sum(s0); s1 = wave_sum(s1);
#pragma unroll
        for (int j = 0; j < 2; ++j) { const int col = 8 * lane + 512 * j;
            *(GAS v4u*)(XB + blk_off(m0, col, D)) = pack8(v[j][0], v[j][1]); *(GAS v4u*)(XB + blk_off(m1, col, D)) = pack8(w[j][0], w[j][1]); }
        if (m0 < MP) {
            if (lane < 2) *(GAS f32x4*)(SS + (size_t)m0 * 8 + 4 * lane) = (f32x4){lane == 0 ? s0 : 0.f, 0.f, 0.f, 0.f};
            else if (lane < 4) *(GAS f32x4*)(SS + (size_t)m1 * 8 + 4 * (lane - 2)) = (f32x4){lane == 2 ? s1 : 0.f, 0.f, 0.f, 0.f};
        } else if (lane < 8) {
            *(GAS f32x4*)((float*)(ws + WS_SSS) + (size_t)(m0 - MP) * 16 + 4 * lane) = (f32x4){lane == 0 ? s0 : (lane == 4 ? s1 : 0.f), 0.f, 0.f, 0.f}; }
    }
}
constexpr int CC_PER_B = 31744 / 4, CC_TOT = 2 * DECB * CC_PER_B, CC_NC = CC_TOT / 256;
static_assert(CC_TOT % 256 == 0, "cache copy chunks");
__device__ __forceinline__ void cache_chunk_step(Frame& F) {
    const int lane = lane_id_opaque();
    const int c = F.vcu * NWAVES + F.wave + F.cck * (F.G * NWAVES);
    if (c < CC_NC) {
        f32x4 val[4]; float* dst[4];
#pragma unroll
        for (int q = 0; q < 4; ++q) { const int i = c * 256 + q * 64 + lane;
            const int which = i / (DECB * CC_PER_B), r = i % (DECB * CC_PER_B), b = r / CC_PER_B, e = r % CC_PER_B;
            const float* src = (which ? KIN(3) : KIN(2)) + (size_t)b * 32768 + 1024 + (size_t)e * 4;
            dst[q] = KOUT() + (which ? OFF_NV_S : OFF_NK_S) + (size_t)b * 32768 + (size_t)e * 4;
            val[q] = *(const GAS f32x4*)src; }
#pragma unroll
        for (int q = 0; q < 4; ++q) *(GAS f32x4*)dst[q] = val[q];
    }
}

using pg8::Unit;
__device__ __forceinline__ float msq_of(f32x4 a, f32x4 b) { const f32x2 s = ((f32x2){a.x, a.y} + (f32x2){a.z, a.w}) + ((f32x2){b.x, b.y} + (f32x2){b.z, b.w}); return (s.x + s.y) * (1.0f / D) + EPS; }
__device__ __forceinline__ float rstd_of(f32x4 a, f32x4 b) { return __builtin_amdgcn_rsqf(msq_of(a, b)); }
#ifndef ST_BUF
#define ST_BUF 0
#endif
#if ST_BUF
typedef __amdgpu_buffer_rsrc_t rsrc_t;
__device__ __forceinline__ rsrc_t ws_rsrc(unsigned char* ws) { return __builtin_amdgcn_make_buffer_rsrc(ws, 0, 0x20000000, 0x00020000); }
__device__ __forceinline__ void st16_wt(rsrc_t r, size_t byte_off, v4u v) { __builtin_amdgcn_raw_buffer_store_b128(v, r, (int)byte_off, 0, 0); }
#else
typedef unsigned char* rsrc_t;
__device__ __forceinline__ rsrc_t ws_rsrc(unsigned char* ws) { return ws; }
__device__ __forceinline__ void st16_wt(rsrc_t r, size_t byte_off, v4u v) { __builtin_nontemporal_store(v, (v4u*)(r + byte_off)); }
#endif
struct NoPre {};
struct OpQKV { static constexpr bool CUSTOM = false, PAIRED = false, NEEDS_RSTD = true, HAS_SS = false, WANTS_MSQ = false; typedef NoPre Pre;
    rsrc_t R; const float* SS; float* out;
    __device__ __forceinline__ void init() { unsigned char* ws = KWS(); out = KOUT(); R = ws_rsrc(ws); SS = (const float*)(ws + WS_SS); }
    __device__ __forceinline__ void prep(int, int) {}
    __device__ __forceinline__ Pre preload(int, int, int) const { return Pre{}; }
    __device__ __forceinline__ float apply(int row, int pn, int c, float rs, f32x4 v0, f32x4 v1, const Pre&) const {
        v0 = v0 * rs; v1 = v1 * rs;
        if (pn < 4) { v0 = v0 * C2; v1 = v1 * C2; st16_wt(R, WS_Q + blk_off(row, pn * 256 + c, D) * 2, pack8(v0, v1)); }
        else { st16_wt(R, (pn == 4 ? WS_K : WS_V) + blk_off(row, c, 256) * 2, pack8(v0, v1));
            float* o = nullptr;
            if (row < MP) { const int t = row & (SEQ - 1); if (t >= SEQ - 128) o = out + (pn == 4 ? OFF_NK_P : OFF_NV_P) + (size_t)((row >> 13) * 128 + t - (SEQ - 128)) * 256 + c; }
            else { const int rr = row - MP; o = out + (pn == 4 ? OFF_NK_S : OFF_NV_S) + (size_t)((rr >> 2) * 128 + 124 + (rr & 3)) * 256 + c; }
            if (o) { *(f32x4*)o = v0; *(f32x4*)(o + 4) = v1; } }
        return 0.f; }
};
struct OpRes { static constexpr bool CUSTOM = false, PAIRED = false, NEEDS_RSTD = false, HAS_SS = true, WANTS_MSQ = false; struct Pre { v4u w; };
    bf16* XB; float* SS; rsrc_t R;
    __device__ __forceinline__ void init() { unsigned char* ws = KWS(); XB = (bf16*)(ws + WS_XB); SS = (float*)(ws + WS_SS); R = ws_rsrc(ws); }
    __device__ __forceinline__ void prep(int, int) {}
    __device__ __forceinline__ Pre preload(int row, int pn, int c) const { Pre p; p.w = *(const v4u*)(XB + blk_off(row, pn * 256 + c, D)); return p; }
    __device__ __forceinline__ float apply(int row, int pn, int c, float, f32x4 v0, f32x4 v1, const Pre& p) const {
        const v4u w = p.w;
        v0[0] += bflo(w.x); v0[1] += bfhi(w.x); v0[2] += bflo(w.y); v0[3] += bfhi(w.y); v1[0] += bflo(w.z); v1[1] += bfhi(w.z); v1[2] += bflo(w.w); v1[3] += bfhi(w.w);
        st16_wt(R, WS_XB + blk_off(row, pn * 256 + c, D) * 2, pack8(v0, v1));
        const f32x4 sq = v0 * v0 + v1 * v1; return (sq[0] + sq[1]) + (sq[2] + sq[3]); }
};
struct OpSwiglu { static constexpr bool CUSTOM = false, PAIRED = true, NEEDS_RSTD = true, HAS_SS = false, WANTS_MSQ = true; typedef NoPre Pre;
    rsrc_t R; const float* SS;
    __device__ __forceinline__ void init() { unsigned char* ws = KWS(); R = ws_rsrc(ws); SS = (const float*)(ws + WS_SS); }
    __device__ __forceinline__ void prep(int, int) {}
    __device__ __forceinline__ Pre preload(int, int, int) const { return Pre{}; }
    __device__ __forceinline__ void apply2(int row, int pn, int c, float msq, f32x4 g0, f32x4 g1, f32x4 u0, f32x4 u1, const Pre&) const {
        const float c1 = -LOG2E * __builtin_amdgcn_rsqf(msq);
        const f32x4 x0 = g0 * c1, x1 = g1 * c1;
        const f32x4 e0 = {ex2(x0[0]), ex2(x0[1]), ex2(x0[2]), ex2(x0[3])}, e1 = {ex2(x1[0]), ex2(x1[1]), ex2(x1[2]), ex2(x1[3])};
        const f32x4 d0 = e0 * msq + msq, d1 = e1 * msq + msq;
        const f32x4 q0 = {rcpf_(d0[0]), rcpf_(d0[1]), rcpf_(d0[2]), rcpf_(d0[3])}, q1 = {rcpf_(d1[0]), rcpf_(d1[1]), rcpf_(d1[2]), rcpf_(d1[3])};
        const f32x4 h0 = (g0 * u0) * q0, h1 = (g1 * u1) * q1;
        st16_wt(R, WS_H + blk_off(row, pn * 128 + c, DFF) * 2, pack8(h0, h1));
#if defined(PROBE_ST2) && PROBE_ST2
        st16_wt(R, WS_LA + blk_off(row & 16383, pn * 128 + c, DFF) * 2, pack8(h1, h0));
#endif
    }
};
template <int K> __device__ __forceinline__ float dpp_hist(float cur, float prev) {
    const int o = __builtin_amdgcn_update_dpp(0, __builtin_bit_cast(int, prev), 0x120 + K, 0xf, 0xf, true);
    const int r = __builtin_amdgcn_update_dpp(o, __builtin_bit_cast(int, cur), 0x110 + K, 0xf, 0xf, false);
    return __builtin_bit_cast(float, r); }
__device__ __forceinline__ f32x4 gelu_tanh4(f32x4 g) { constexpr float K0 = -2.0f * LOG2E * 0.7978845608028654f, K1 = K0 * 0.044715f;
    const f32x4 t = (g * g) * K1 + K0, z = t * g; const f32x4 d = (f32x4){ex2(z[0]), ex2(z[1]), ex2(z[2]), ex2(z[3])} + 1.0f;
    return g * (f32x4){rcpf_(d[0]), rcpf_(d[1]), rcpf_(d[2]), rcpf_(d[3])}; }
__device__ __forceinline__ float gelu_tanh_f(float g) { const float z = 0.7978845608028654f * (g + 0.044715f * g * g * g); return g * rcpf_(1.0f + ex2(-2.0f * LOG2E * z)); }
struct OpRecIn { static constexpr bool CUSTOM = true, PAIRED = false, NEEDS_RSTD = true, HAS_SS = false, WANTS_MSQ = false; typedef NoPre Pre;
    rsrc_t R; unsigned char* W; const float* SS; float* out;
    __device__ __forceinline__ void init() { unsigned char* ws = KWS(); out = KOUT(); R = ws_rsrc(ws); W = ws; SS = (const float*)(ws + WS_SS); }
    __device__ __forceinline__ void prep(int, int) {}
    __device__ __forceinline__ Pre preload(int, int, int) const { return Pre{}; }
    __device__ __forceinline__ float apply(int, int, int, float, f32x4, f32x4, const Pre&) const { return 0.f; }
    __device__ __forceinline__ void custom(const f32x4 (&acc)[2][2][4][2], const Unit& u, int wr, int wc, int fr, int fq, const float (&rsv)[2][4]) const {
        const int pn = u.pn, c0 = wc * 32 + 8 * fq;
        if (pn < 4) {
#pragma unroll
            for (int ai = 0; ai < 2; ++ai)
#pragma unroll
                for (int m = 0; m < 4; ++m) { const int row = u.pm * 256 + ai * 128 + wr * 64 + m * 16 + fr; const float rs = rsv[ai][m];
#pragma unroll
                    for (int bj = 0; bj < 2; ++bj) { f32x4 v0 = acc[ai][bj][m][0] * rs, v1 = acc[ai][bj][m][1] * rs;
                        v0 = gelu_tanh4(v0); v1 = gelu_tanh4(v1);
                        st16_wt(R, WS_GG + blk_off(row, pn * 256 + bj * 128 + c0, D) * 2, pack8(v0, v1)); } }
        } else {
            const float* cwp = KIN(12); const float* cbp = KIN(13);
#pragma unroll
            for (int bj = 0; bj < 2; ++bj)
#pragma unroll
              for (int n = 0; n < 2; ++n) { const int col = (pn - 4) * 256 + bj * 128 + c0 + 4 * n;
                asm volatile("" ::: "memory");
                const f32x4 cb = *(const f32x4*)(cbp + col), w0 = *(const f32x4*)(cwp + col), w1 = *(const f32x4*)(cwp + D + col), w2 = *(const f32x4*)(cwp + 2 * D + col), w3 = *(const f32x4*)(cwp + 3 * D + col);
#pragma unroll
                for (int ai = 0; ai < 2; ++ai) { f32x4 prev = (f32x4){0.f, 0.f, 0.f, 0.f};
#pragma unroll
                    for (int m = 0; m < 4; ++m) { const int row = u.pm * 256 + ai * 128 + wr * 64 + m * 16 + fr;
                        const f32x4 cur = acc[ai][bj][m][n] * rsv[ai][m]; f32x4 h1, h2, h3;
#pragma unroll
                        for (int e = 0; e < 4; ++e) { h1[e] = dpp_hist<1>(cur[e], prev[e]); h2[e] = dpp_hist<2>(cur[e], prev[e]); h3[e] = dpp_hist<3>(cur[e], prev[e]); }
                        const f32x4 xc = cb + w3 * cur + w2 * h1 + w1 * h2 + w0 * h3; prev = cur;
                        if (m > 0 || fr >= 3) { v2u w; w.x = pk2(xc[0], xc[1]); w.y = pk2(xc[2], xc[3]); *(v2u*)(W + WS_XC + blk_off(row, col, D) * 2) = w; }
                        if ((m == 0 && fr < 3) || (m == 3 && fr >= 13)) { v2u w; w.x = pk2(cur[0], cur[1]); w.y = pk2(cur[2], cur[3]); *(v2u*)(W + WS_XBC + ((size_t)row * D + col) * 2) = w; }
                        const int t = row & (SEQ - 1);
                        if (t >= SEQ - 3) *(f32x4*)(out + OFF_NC_P + (size_t)((row >> 13) * 3 + t - (SEQ - 3)) * D + col) = cur;
                        asm volatile("" ::: "memory"); } } }
        }
    }
    __device__ __forceinline__ void custom_sk(int row, int r, int uc, int pn, int c, f32x4 v0, f32x4 v1, LAS float* T0, float rs) const {
        v0 = v0 * rs; v1 = v1 * rs;
        if (pn < 4) {
            v0 = gelu_tanh4(v0); v1 = gelu_tanh4(v1);
            st16_wt(R, WS_GG + blk_off(row, pn * 256 + c, D) * 2, pack8(v0, v1));
        } else { *(LAS f32x4*)(T0 + r * 132 + uc) = v0; *(LAS f32x4*)(T0 + r * 132 + uc + 4) = v1; }
        __syncthreads();
        if (pn >= 4) { const int rr = row - MP, t = rr & 3, bsm = rr >> 2, col = (pn - 4) * 256 + c;
            const float* cwp = KIN(12); const float* cbp = KIN(13); const float* cs = KIN(4);
            f32x4 x0 = *(const f32x4*)(cbp + col), x1 = *(const f32x4*)(cbp + col + 4);
            x0 = x0 + *(const f32x4*)(cwp + 3 * D + col) * v0; x1 = x1 + *(const f32x4*)(cwp + 3 * D + col + 4) * v1;
#pragma unroll
            for (int k = 1; k <= 3; ++k) { f32x4 h0, h1;
                if (t >= k) { h0 = *(const LAS f32x4*)(T0 + (r - k) * 132 + uc); h1 = *(const LAS f32x4*)(T0 + (r - k) * 132 + uc + 4); }
                else { const float* p = cs + ((size_t)bsm * 3 + (t + 3 - k)) * D + col; h0 = *(const f32x4*)p; h1 = *(const f32x4*)(p + 4); }
                x0 = x0 + *(const f32x4*)(cwp + (3 - k) * D + col) * h0; x1 = x1 + *(const f32x4*)(cwp + (3 - k) * D + col + 4) * h1; }
            st16_wt(R, WS_XC + blk_off(row, col, D) * 2, pack8(x0, x1));
            if (t >= 1) { float* o = out + OFF_NC_S + (size_t)(bsm * 3 + t - 1) * D + col; *(f32x4*)o = v0; *(f32x4*)(o + 4) = v1; } }
    }
};
struct OpGates { static constexpr bool CUSTOM = false, PAIRED = true, NEEDS_RSTD = false, HAS_SS = false, WANTS_MSQ = false; struct Pre { v4u w; };
    const bf16* XC; rsrc_t R; const float* SS; f32x4 brL[2], biL[2], c8[2];
    __device__ __forceinline__ void init() { unsigned char* ws = KWS(); XC = (const bf16*)(ws + WS_XC); R = ws_rsrc(ws); SS = nullptr; }
    __device__ __forceinline__ void prep(int pn, int c) { const int d0 = (pn >> 1) * 256 + (pn & 1) * 128 + c; const float* brg = KIN(15); const float* big = KIN(17); const float* lam = KIN(18);
#pragma unroll
        for (int e = 0; e < 8; ++e) { brL[e >> 2][e & 3] = LOG2E * brg[d0 + e]; biL[e >> 2][e & 3] = LOG2E * big[d0 + e]; const float ee = ex2(-lam[d0 + e] * LOG2E);
            const float sp = ee > 0.03f ? __logf(1.0f + ee) : ee * (1.0f + ee * (-0.5f + ee * (0.33333334f - 0.25f * ee))); c8[e >> 2][e & 3] = -8.0f * LOG2E * sp; } }
    __device__ __forceinline__ Pre preload(int row, int pn, int c) const { Pre p; p.w = *(const v4u*)(XC + blk_off(row, (pn >> 1) * 256 + (pn & 1) * 128 + c, D)); return p; }
    __device__ __forceinline__ void apply2(int row, int pn, int c, float, f32x4 r0, f32x4 r1, f32x4 i0, f32x4 i1, const Pre& p) const {
        const int d0 = (pn >> 1) * 256 + (pn & 1) * 128 + c;
        const v4u xw = p.w;
        const f32x4 xc[2] = {(f32x4){bflo(xw.x), bfhi(xw.x), bflo(xw.y), bfhi(xw.y)}, (f32x4){bflo(xw.z), bfhi(xw.z), bflo(xw.w), bfhi(xw.w)}};
        h16x8 la8, bb8;
#pragma unroll
        for (int hh = 0; hh < 2; ++hh) {
            const f32x4 tr = (hh ? r1 : r0) * LOG2E + brL[hh], ti = (hh ? i1 : i0) * LOG2E + biL[hh];
            const f32x4 er = (f32x4){ex2(-tr[0]), ex2(-tr[1]), ex2(-tr[2]), ex2(-tr[3])} + 1.0f, ei = (f32x4){ex2(-ti[0]), ex2(-ti[1]), ex2(-ti[2]), ex2(-ti[3])} + 1.0f;
            const f32x4 r = {rcpf_(er[0]), rcpf_(er[1]), rcpf_(er[2]), rcpf_(er[3])}, ig = {rcpf_(ei[0]), rcpf_(ei[1]), rcpf_(ei[2]), rcpf_(ei[3])};
            const f32x4 la2 = r * c8[hh];
            const f32x4 b = ig * xc[hh];
#pragma unroll
            for (int e = 0; e < 4; ++e) { la8[4 * hh + e] = (_Float16)la2[e]; bb8[4 * hh + e] = (_Float16)b[e]; } }
        st16_wt(R, WS_LA + blk_off(row, d0, D) * 2, __builtin_bit_cast(v4u, la8)); st16_wt(R, WS_BB + blk_off(row, d0, D) * 2, __builtin_bit_cast(v4u, bb8)); }
};
constexpr int RSB_OFF = LDSCTL_OFF + 1024 + 4096;
constexpr int RED_OFF = LDSCTL_OFF + 1024;
template <class Op> struct Epi8 { static constexpr bool PERM = true, AFTER_DRAIN = false, IDEMP = !Op::HAS_SS;
    LAS unsigned char* lds;
    __device__ __forceinline__ void first_unit(const Unit& u, int wid) const {
        if constexpr (Op::NEEDS_RSTD) { const int t = wid * 64 + lane_id_opaque();
            if (t < 256) { const float* sp = (const float*)(KWS() + WS_SS) + (unsigned)(u.pm * 256 + t) * 8u; ((LAS float*)(lds + RSB_OFF))[t] = msq_of(*(const f32x4*)sp, *(const f32x4*)(sp + 4)); } } }
    __device__ __forceinline__ void operator()(const f32x4 (&acc_in)[2][2][4][2], const Unit& u, const Unit& nu, bool has_next, int ui, int wr, int wc, int, int) const {
        const int lane_ = lane_id_opaque(), fr = lane_ & 15, fq = lane_ >> 4;
        Op op; op.init();
        const int pn = u.pn, c0 = wc * 32 + 8 * fq;
        op.prep(pn, c0);
#if (defined(PROBE_K2) && PROBE_K2) || (defined(PROBE_MMA2) && PROBE_MMA2)
        f32x4 acc[2][2][4][2];
#pragma unroll
        for (int a_ = 0; a_ < 2; ++a_)
#pragma unroll
            for (int b_ = 0; b_ < 2; ++b_)
#pragma unroll
                for (int m_ = 0; m_ < 4; ++m_)
#pragma unroll
                    for (int n_ = 0; n_ < 2; ++n_) acc[a_][b_][m_][n_] = acc_in[a_][b_][m_][n_] * 0.5f;
#else
        const f32x4 (&acc)[2][2][4][2] = acc_in;
#endif
        LAS float* red = (LAS float*)(lds + RED_OFF);
        f32x4 nsa = (f32x4){0.f, 0.f, 0.f, 0.f}, nsb = nsa;
        const int tq_ = (wr * 4 + wc) * 64 + lane_; const bool nprep_ = Op::NEEDS_RSTD && has_next && tq_ < 256;
        if constexpr (Op::NEEDS_RSTD) { if (nprep_) { const float* sp_ = op.SS + (unsigned)(nu.pm * 256 + tq_) * 8u; nsa = *(const f32x4*)sp_; nsb = *(const f32x4*)(sp_ + 4); } }
        float msv[2][4];
        if constexpr (Op::NEEDS_RSTD) { const LAS float* rsb_ = (const LAS float*)(lds + RSB_OFF) + (ui & 1) * 256 + wr * 64 + fr;
#pragma unroll
            for (int ai = 0; ai < 2; ++ai)
#pragma unroll
                for (int m = 0; m < 4; ++m) msv[ai][m] = rsb_[ai * 128 + m * 16]; }
        if constexpr (Op::CUSTOM) { float rsv[2][4];
#pragma unroll
            for (int ai = 0; ai < 2; ++ai)
#pragma unroll
                for (int m = 0; m < 4; ++m) rsv[ai][m] = __builtin_amdgcn_rsqf(msv[ai][m]);
            asm volatile("" ::: "memory");
            op.custom(acc, u, wr, wc, fr, fq, rsv);
            if (nprep_) ((LAS float*)(lds + RSB_OFF))[((ui + 1) & 1) * 256 + tq_] = msq_of(nsa, nsb);
            return; }
        typename Op::Pre pa[2][4], pb[2][4];
#pragma unroll
        for (int ai = 0; ai < 2; ++ai)
#pragma unroll
            for (int m = 0; m < 4; ++m) { const int row = u.pm * 256 + ai * 128 + wr * 64 + m * 16 + fr;
                pa[ai][m] = op.preload(row, pn, c0); if constexpr (!Op::PAIRED) pb[ai][m] = op.preload(row, pn, 128 + c0); }
#pragma unroll
        for (int ai = 0; ai < 2; ++ai) {
#pragma unroll
            for (int m = 0; m < 4; ++m) { const int rl = ai * 128 + wr * 64 + m * 16 + fr, row = u.pm * 256 + rl;
                float rs = 1.0f; if constexpr (Op::NEEDS_RSTD) rs = Op::WANTS_MSQ ? msv[ai][m] : __builtin_amdgcn_rsqf(msv[ai][m]);
                if constexpr (Op::PAIRED) op.apply2(row, pn, c0, rs, acc[ai][0][m][0], acc[ai][0][m][1], acc[ai][1][m][0], acc[ai][1][m][1], pa[ai][m]);
                else { float ssq = op.apply(row, pn, c0, rs, acc[ai][0][m][0], acc[ai][0][m][1], pa[ai][m]) + op.apply(row, pn, 128 + c0, rs, acc[ai][1][m][0], acc[ai][1][m][1], pb[ai][m]);
                    if constexpr (Op::HAS_SS) { ssq += __shfl_xor(ssq, 16); ssq += __shfl_xor(ssq, 32); if (fq == 0) red[rl * 4 + wc] = ssq; } } }
            asm volatile("" ::: "memory");
        }
        if constexpr (Op::NEEDS_RSTD) { if (nprep_) ((LAS float*)(lds + RSB_OFF))[((ui + 1) & 1) * 256 + tq_] = msq_of(nsa, nsb); }
        if constexpr (Op::HAS_SS) {
            asm volatile("s_waitcnt lgkmcnt(0)" ::: "memory"); __builtin_amdgcn_s_barrier(); asm volatile("" ::: "memory");
            const int t = (wr * 4 + wc) * 64 + lane_;
            if (t < 256) { const f32x4 r = *(const LAS f32x4*)(red + t * 4); *(f32x2*)(op.SS + (size_t)(u.pm * 256 + t) * 8 + 2 * pn) = (f32x2){r.x + r.y, r.z + r.w}; }
        }
    }
};
#ifndef PROBE_SK_RES
#define PROBE_SK_RES 0
#endif
#define SK_LOAD(fa, fb, bi) do { _Pragma("unroll") for (int i_ = 0; i_ < 4; ++i_) { fa[i_] = *(const bf16x8*)(ap + ((bi) * 2 + (i_ >> 1)) * 512 + 16 * (i_ & 1)); \
        fb[i_][0] = *(const bf16x8*)(bp + ((bi) * 2 + (i_ >> 1)) * 512 + 16 * (i_ & 1)); fb[i_][1] = *(const bf16x8*)(bp + (size_t)ldb * 32 + ((bi) * 2 + (i_ >> 1)) * 512 + 16 * (i_ & 1)); } } while (0)
#define SK_MMA(fa, fb) do { _Pragma("unroll") for (int i_ = 0; i_ < 4; ++i_) { acc0 = __builtin_amdgcn_mfma_f32_32x32x16_bf16(fa[i_], fb[i_][0], acc0, 0, 0, 0); acc1 = __builtin_amdgcn_mfma_f32_32x32x16_bf16(fa[i_], fb[i_][1], acc1, 0, 0, 0); } } while (0)
template <class Op, bool C64> __device__ __forceinline__ void skinny_phase(Frame& F, const bf16* A, int lda, int acol_shift, int acol_elems, const bf16* Bt, int ldb, int K, int npn, int kbeg, int kend) {
    static_assert(!C64 || (!Op::PAIRED && !Op::CUSTOM), "64-column units: plain ops only");
    static_assert(!Op::HAS_SS || C64, "row statistics of the sample rows: 16 slots, all rewritten by the 64-column units of a residual GEMM");
    constexpr int NS = C64 ? 8 : 4, TW = C64 ? 68 : 132, SK_T = 32 * TW, USH = C64 ? 6 : 5, JM = C64 ? 3 : 1;
    const int lane = lane_id_opaque(), wid = F.wave, tid = wid * 64 + lane;
    LAS float* T = (LAS float*)F.lds;
    const int kh = C64 ? wid : (wid & 3), cg = C64 ? 0 : (wid >> 2), r32 = lane & 31, hi = lane >> 5;
    const int nbt = K >> 6, nbase = nbt / NS, nrem = nbt - nbase * NS;
    const int nb = nbase + (kh < nrem ? 1 : 0), kst = (kh * nbase + (kh < nrem ? kh : nrem)) * 64;
    bf16x8 a0[4], b0[4][2], a1[4], b1[4][2], a2[4], b2[4][2];
    const bf16* ap = A; const bf16* bp = Bt;
#define SK_SETUP(uu) do { const int pn_ = (uu) >> USH, j_ = ((uu) >> 4) & JM, rb_ = (uu) & 15; \
        { const int m_ = MP + 32 * rb_ + r32; ap = A + ((size_t)(m_ >> 4) * (lda >> 5) + (((pn_ >> acol_shift) * acol_elems + kst) >> 5)) * 512 + (m_ & 15) * 32 + 8 * hi; } \
        { const int n_ = pn_ * 256 + (C64 ? 64 * j_ : (cg == 0 ? 64 * j_ : 128 + 64 * j_)) + r32; bp = Bt + ((size_t)(n_ >> 4) * (ldb >> 5) + (kst >> 5)) * 512 + (n_ & 15) * 32 + 8 * hi; } } while (0)
    if (kbeg >= kend) return;
    { SK_SETUP(F.vcu + kbeg * F.G); SK_LOAD(a0, b0, 0); if (nb > 1) SK_LOAD(a1, b1, 1); }
    const int uend = F.vcu + kend * F.G;
    for (int u = F.vcu + kbeg * F.G; u < uend; u += F.G) {
        const int pn = u >> USH, j = (u >> 4) & JM, rb = u & 15;
        Op op; op.init();
        const bool eact_ = !C64 || tid < 256;
        const int er_ = C64 ? ((tid >> 3) & 31) : (tid >> 4), egrp_ = C64 ? (tid & 7) : (tid & 15), erow_ = MP + 32 * rb + er_;
        const int ec_ = C64 ? 64 * j + 8 * egrp_ : (Op::PAIRED ? 64 * j + 8 * (egrp_ & 7) : (egrp_ < 8 ? 64 * j + 8 * egrp_ : 128 + 64 * j + 8 * egrp_ - 64));
        f32x4 ess0_ = (f32x4){0.f, 0.f, 0.f, 0.f}, ess1_ = ess0_;
        if constexpr (Op::NEEDS_RSTD) { const float* sp_ = (const float*)(KWS() + WS_SSS) + (size_t)(erow_ - MP) * 16;
            ess0_ = *(const f32x4*)sp_ + *(const f32x4*)(sp_ + 4); ess1_ = *(const f32x4*)(sp_ + 8) + *(const f32x4*)(sp_ + 12); }
        typename Op::Pre epre_ = op.preload(erow_, pn, ec_);
        f32x16 acc0 = {}, acc1 = {};
        if (nb > 2) SK_LOAD(a2, b2, 2);
        for (int b = 0;;) {
            __builtin_amdgcn_sched_barrier(0); SK_MMA(a0, b0); __builtin_amdgcn_sched_barrier(0);
            if (b + 3 < nb) SK_LOAD(a0, b0, b + 3);
            if (++b >= nb) break;
            __builtin_amdgcn_sched_barrier(0); SK_MMA(a1, b1); __builtin_amdgcn_sched_barrier(0);
            if (b + 3 < nb) SK_LOAD(a1, b1, b + 3);
            if (++b >= nb) break;
            __builtin_amdgcn_sched_barrier(0); SK_MMA(a2, b2); __builtin_amdgcn_sched_barrier(0);
            if (b + 3 < nb) SK_LOAD(a2, b2, b + 3);
            if (++b >= nb) break;
        }
        if (u + F.G < uend) { SK_SETUP(u + F.G); SK_LOAD(a0, b0, 0); if (nb > 1) SK_LOAD(a1, b1, 1); }
#pragma unroll
        for (int i = 0; i < 16; ++i) { const int rr = (i & 3) + 8 * (i >> 2) + 4 * hi; T[kh * SK_T + rr * TW + 64 * cg + r32] = acc0[i]; T[kh * SK_T + rr * TW + 64 * cg + 32 + r32] = acc1[i]; }
        __syncthreads();
        { const int r = er_, grp = egrp_, row = erow_;
#define SK_SUM4(p) (*(const LAS f32x4*)(p) + *(const LAS f32x4*)((p) + SK_T) + *(const LAS f32x4*)((p) + 2 * SK_T) + *(const LAS f32x4*)((p) + 3 * SK_T))
#define SK_SUMS(p) (C64 ? (SK_SUM4(p) + SK_SUM4((p) + 4 * SK_T)) : SK_SUM4(p))
          if constexpr (Op::CUSTOM) {
              const int uc = 8 * grp, c = uc < 64 ? 64 * j + uc : 128 + 64 * j + uc - 64;
              const LAS float* t0 = T + r * TW + uc;
              const f32x4 v0 = SK_SUM4(t0), v1 = SK_SUM4(t0 + 4);
              op.custom_sk(row, r, uc, pn, c, v0, v1, T, rstd_of(ess0_, ess1_));
          } else if constexpr (Op::PAIRED) {
              if (grp < 8) { const int c = 64 * j + 8 * grp; op.prep(pn, c);
                  const LAS float* t0 = T + r * TW + 8 * grp;
                  const f32x4 g0 = SK_SUM4(t0), g1 = SK_SUM4(t0 + 4), u0 = SK_SUM4(t0 + 64), u1 = SK_SUM4(t0 + 68);
                  float rs = 1.0f; if constexpr (Op::NEEDS_RSTD) rs = Op::WANTS_MSQ ? msq_of(ess0_, ess1_) : rstd_of(ess0_, ess1_);
                  op.apply2(row, pn, c, rs, g0, g1, u0, u1, epre_); }
          } else if (eact_) {
              const int uc = 8 * grp, c = ec_; op.prep(pn, c);
              const LAS float* t0 = T + r * TW + uc;
              f32x4 v0 = SK_SUMS(t0), v1 = SK_SUMS(t0 + 4);
              if (PROBE_SK_RES && F.dry) { v0 = v0 * 0.f; v1 = v1 * 0.f; }
              float rs = 1.0f; if constexpr (Op::NEEDS_RSTD) rs = rstd_of(ess0_, ess1_);
              float ssq = op.apply(row, pn, c, rs, v0, v1, epre_);
              if constexpr (Op::HAS_SS) { ssq += __shfl_xor(ssq, 1); ssq += __shfl_xor(ssq, 2); ssq += __shfl_xor(ssq, 4); if constexpr (!C64) ssq += __shfl_xor(ssq, 8);
                  if (grp == 0) ((float*)(KWS() + WS_SSS))[(size_t)(row - MP) * 16 + (C64 ? 4 * pn + j : 2 * pn + j)] = ssq; }
          } }
#undef SK_SUM4
#undef SK_SUMS
        __syncthreads();
    }
#undef SK_SETUP
}
__device__ __forceinline__ int crow(int r, int hi) { return (r & 3) + 8 * (r >> 2) + 4 * hi; }
typedef short v4i16_t __attribute__((ext_vector_type(4)));
__device__ __forceinline__ s16x4 vtr(LAS const unsigned char* p) { return __builtin_bit_cast(s16x4, __builtin_amdgcn_ds_read_tr16_b64_v4i16((LAS v4i16_t*)p)); }
constexpr int AT_KS = 0, AT_VS = 27648, AT_WSF = 55296, AT_OST = 56320, AT_ROWB = 144;
constexpr int AT_NU = BATCH * 128 * NKV;
struct AttnPre { v4u kv[3], vv[3]; bf16x8 qr[4]; };
__device__ __forceinline__ void attn_prefetch(AttnPre& P, int u, int tid, int wid, int r32, int hi, const bf16* Q, const bf16* Kb, const bf16* Vb) {
    const int g = u & 3, qb = (u >> 2) & 127, b = u >> 9; const int t0 = qb * 64 - 128; const size_t rowbase = (size_t)b * SEQ;
#pragma unroll
    for (int i = 0; i < 3; ++i) { const int idx = tid + 512 * i, r = idx >> 3, ch = idx & 7, t = t0 + r;
        P.kv[i] = (v4u){0u, 0u, 0u, 0u}; P.vv[i] = (v4u){0u, 0u, 0u, 0u};
        if (t >= 0) { const size_t o_ = blk_off((int)rowbase + t, g * 64 + ch * 8, 256); P.kv[i] = *(const v4u*)(Kb + o_); P.vv[i] = *(const v4u*)(Vb + o_); } }
    const int h = 4 * g + (wid >> 1), tq0 = qb * 64 + 32 * (wid & 1);
#pragma unroll
    for (int d0 = 0; d0 < 4; ++d0) P.qr[d0] = *(const bf16x8*)(Q + blk_off((int)rowbase + tq0 + r32, h * 64 + d0 * 16 + hi * 8, D));
}
__device__ __forceinline__ void attn_prompt_units(Frame& F, const bf16* Q, const bf16* Kb, const bf16* Vb, bf16* O, const float* sinks) {
    const int lane = lane_id_opaque(), wid = F.wave, tid = wid * 64 + lane, r32 = lane & 31, hi = lane >> 5;
    LAS unsigned char* lds = F.lds;
    AttnPre P;
    int u = F.vcu;
    if (u < AT_NU) attn_prefetch(P, u, tid, wid, r32, hi, Q, Kb, Vb);
    for (; u < AT_NU; u += F.G) {
    const int g = u & 3, qb = (u >> 2) & 127, b = u >> 9; const size_t rowbase = (size_t)b * SEQ;
#pragma unroll
    for (int i = 0; i < 3; ++i) { const int idx = tid + 512 * i, r = idx >> 3, ch = idx & 7;
        *(LAS v4u*)(lds + AT_KS + r * AT_ROWB + ch * 16) = P.kv[i]; *(LAS v4u*)(lds + AT_VS + r * AT_ROWB + ch * 16) = P.vv[i]; }
    bf16x8 qr[4];
#pragma unroll
    for (int d0 = 0; d0 < 4; ++d0) qr[d0] = P.qr[d0];
    __syncthreads();
    if (u + F.G < AT_NU) attn_prefetch(P, u + F.G, tid, wid, r32, hi, Q, Kb, Vb);
    const int h = 4 * g + (wid >> 1), s = wid & 1, tq0 = qb * 64 + 32 * s;
    f32x16 p[5];
#pragma unroll
    for (int c = 0; c < 5; ++c) { f32x16 a = {};
#pragma unroll
        for (int d0 = 0; d0 < 4; ++d0) { const bf16x8 kf = *(const LAS bf16x8*)(lds + AT_KS + (32 * s + 32 * c + r32) * AT_ROWB + (d0 * 16 + hi * 8) * 2); a = __builtin_amdgcn_mfma_f32_32x32x16_bf16(kf, qr[d0], a, 0, 0, 0); }
        p[c] = a; }
    const float slope2 = ex2(-0.5f * (float)(h + 1)) * LOG2E, sink2 = sinks[h] * LOG2E;
    int base = r32 - 4 * hi + 128; asm volatile("" : "+v"(base));
    const float sb = slope2 * (float)base; const int kmin = 128 - tq0 - 4 * hi; const bool head = tq0 < 128;
    f32x16 tb;
#pragma unroll
    for (int r = 0; r < 16; ++r) tb[r] = fmaf(slope2, (float)((r & 3) + 8 * (r >> 2)), -sb);
#pragma unroll
    for (int c = 0; c < 5; ++c) { p[c] = p[c] + (tb + slope2 * (32.0f * (float)c));
#pragma unroll
        for (int r = 0; r < 16; ++r) { const int kc = 32 * c + (r & 3) + 8 * (r >> 2);
            if (c == 0) p[c][r] = (kc >= base - 128) ? p[c][r] : -1e30f;
            if (c == 4) p[c][r] = (kc <= base) ? p[c][r] : -1e30f; } }
    if (head) {
#pragma unroll
        for (int c = 0; c < 5; ++c)
#pragma unroll
            for (int r = 0; r < 16; ++r) { const int kc = 32 * c + (r & 3) + 8 * (r >> 2); p[c][r] = (kc >= kmin) ? p[c][r] : -1e30f; } }
    float mx = sink2;
#pragma unroll
    for (int c = 0; c < 5; ++c)
#pragma unroll
        for (int r = 0; r < 16; ++r) mx = fmaxf(mx, p[c][r]);
    mx = fmaxf(mx, __shfl_xor(mx, 32));
    f32x16 lv = f32x16{};
#pragma unroll
    for (int c = 0; c < 5; ++c) { f32x16 d = p[c] - mx;
#pragma unroll
        for (int r = 0; r < 16; ++r) d[r] = ex2(d[r]);
        p[c] = d; lv = lv + d; }
    float l = ((lv[0] + lv[1]) + (lv[2] + lv[3])) + ((lv[4] + lv[5]) + (lv[6] + lv[7])) + (((lv[8] + lv[9]) + (lv[10] + lv[11])) + ((lv[12] + lv[13]) + (lv[14] + lv[15])));
    l += __shfl_xor(l, 32); l += ex2(sink2 - mx);
    f32x16 o[2]; o[0] = f32x16{}; o[1] = f32x16{};
    const int vlane = (4 * hi + ((lane & 15) >> 2)) * AT_ROWB + 32 * ((lane >> 4) & 1) + 8 * (lane & 3);
#pragma unroll
    for (int c = 0; c < 5; ++c)
#pragma unroll
        for (int s2 = 0; s2 < 2; ++s2) {
            v4u pw; pw.x = pk2(p[c][8 * s2 + 0], p[c][8 * s2 + 1]); pw.y = pk2(p[c][8 * s2 + 2], p[c][8 * s2 + 3]); pw.z = pk2(p[c][8 * s2 + 4], p[c][8 * s2 + 5]); pw.w = pk2(p[c][8 * s2 + 6], p[c][8 * s2 + 7]);
            const bf16x8 pa = __builtin_bit_cast(bf16x8, pw);
            const int krow0 = 32 * s + 32 * c + 16 * s2;
#pragma unroll
            for (int dh = 0; dh < 2; ++dh) {
                const s16x4 vlo = vtr(lds + AT_VS + krow0 * AT_ROWB + vlane + 64 * dh), vhi = vtr(lds + AT_VS + (krow0 + 8) * AT_ROWB + vlane + 64 * dh);
                const bf16x8 vf = (bf16x8){vlo[0], vlo[1], vlo[2], vlo[3], vhi[0], vhi[1], vhi[2], vhi[3]};
                o[dh] = __builtin_amdgcn_mfma_f32_32x32x16_bf16(pa, vf, o[dh], 0, 0, 0); }
        }
    LAS float* wsf = (LAS float*)(lds + AT_WSF) + wid * 32;
    if (hi == 0) wsf[r32] = 1.0f / l;
    LDS_WAIT(); asm volatile("" ::: "memory");
    LAS unsigned short* stg = (LAS unsigned short*)(lds + AT_OST + wid * 4352);
#pragma unroll
    for (int r = 0; r < 16; ++r) { const int q = crow(r, hi); const float inv = wsf[q];
        stg[q * 68 + r32] = (unsigned short)(pk2(o[0][r] * inv, 0.f) & 0xffffu); stg[q * 68 + 32 + r32] = (unsigned short)(pk2(o[1][r] * inv, 0.f) & 0xffffu); }
    LDS_WAIT(); asm volatile("" ::: "memory");
#pragma unroll
    for (int i = 0; i < 4; ++i) { const int id = lane + 64 * i, row = id >> 3, ch = id & 7;
        const v2u lo = *(const LAS v2u*)(stg + row * 68 + ch * 8), hi2 = *(const LAS v2u*)(stg + row * 68 + ch * 8 + 4);
        __builtin_nontemporal_store((v4u){lo.x, lo.y, hi2.x, hi2.y}, (v4u*)(O + blk_off((int)(rowbase + tq0) + row, h * 64 + ch * 8, D))); }
    __syncthreads();
    }
}
__device__ __forceinline__ void attn_sample_task(Frame& F, int b, int g, int t, const bf16* Q, const bf16* Kb, const bf16* Vb, bf16* O, const float* ck, const float* cv, const float* sinks) {
    const int lane = lane_id_opaque();
    LAS float* Qs = (LAS float*)(F.lds + F.wave * 4096); LAS float* Pt = Qs + 256;
#pragma unroll
    for (int i = 0; i < 4; ++i) Qs[i * 64 + lane] = bf2f(Q[blk_off(MP + 4 * b + t, (4 * g + i) * 64 + lane, D)]);
    LDS_WAIT(); asm volatile("" ::: "memory");
    for (int j = 0; j < 3; ++j) { const int si = lane + 64 * j;
        if (si < 132) {
            float kv[64];
            if (si < 128) { const f32x4* kp = (const f32x4*)(ck + ((size_t)(b * 128 + si) * 4 + g) * 64);
#pragma unroll
                for (int e = 0; e < 16; ++e) { const f32x4 v = kp[e]; kv[4 * e] = v.x; kv[4 * e + 1] = v.y; kv[4 * e + 2] = v.z; kv[4 * e + 3] = v.w; } }
            else { const int kr_ = MP + 4 * b + si - 128;
#pragma unroll
                for (int e = 0; e < 8; ++e) { const v4u w = *(const v4u*)(Kb + blk_off(kr_, g * 64 + 8 * e, 256)); kv[8 * e] = bflo(w.x); kv[8 * e + 1] = bfhi(w.x); kv[8 * e + 2] = bflo(w.y); kv[8 * e + 3] = bfhi(w.y); kv[8 * e + 4] = bflo(w.z); kv[8 * e + 5] = bfhi(w.z); kv[8 * e + 6] = bflo(w.w); kv[8 * e + 7] = bfhi(w.w); } }
            const int dist = t - si + 128; const bool valid = dist >= 0 && dist <= 128;
            f32x4 sc;
#pragma unroll
            for (int i = 0; i < 4; ++i) { float dt = 0.f;
#pragma unroll
                for (int e = 0; e < 16; ++e) { const f32x4 qv = *(const LAS f32x4*)(Qs + i * 64 + 4 * e); dt += kv[4 * e] * qv.x + kv[4 * e + 1] * qv.y + kv[4 * e + 2] * qv.z + kv[4 * e + 3] * qv.w; }
                const float slope2 = ex2(-0.5f * (float)(4 * g + i + 1)) * LOG2E;
                sc[i] = valid ? dt - slope2 * (float)dist : -1e30f; }
            *(LAS f32x4*)(Pt + si * 4) = sc;
        }
    }
    LDS_WAIT(); asm volatile("" ::: "memory");
    f32x4 x0 = *(const LAS f32x4*)(Pt + lane * 4), x1 = *(const LAS f32x4*)(Pt + (lane + 64) * 4), x2 = lane < 4 ? *(const LAS f32x4*)(Pt + (lane + 128) * 4) : (f32x4){-1e30f, -1e30f, -1e30f, -1e30f};
    float linv[4];
#pragma unroll
    for (int i = 0; i < 4; ++i) { const float sink2 = sinks[4 * g + i] * LOG2E;
        const float mx = fmaxf(wave_max(fmaxf(fmaxf(x0[i], x1[i]), x2[i])), sink2);
        x0[i] = ex2(x0[i] - mx); x1[i] = ex2(x1[i] - mx); x2[i] = ex2(x2[i] - mx);
        linv[i] = 1.0f / (wave_sum(x0[i] + x1[i] + x2[i]) + ex2(sink2 - mx)); }
    *(LAS f32x4*)(Pt + lane * 4) = x0; *(LAS f32x4*)(Pt + (lane + 64) * 4) = x1; if (lane < 4) *(LAS f32x4*)(Pt + (lane + 128) * 4) = x2;
    LDS_WAIT(); asm volatile("" ::: "memory");
    float o0 = 0.f, o1 = 0.f, o2 = 0.f, o3 = 0.f;
    const float* cvp = cv + ((size_t)(b * 128) * 4 + g) * 64 + lane;
#pragma unroll 1
    for (int s0 = 0; s0 < 128; s0 += 32) {
        float v[32];
#pragma unroll
        for (int k = 0; k < 32; ++k) v[k] = cvp[(size_t)(s0 + k) * 256];
#pragma unroll
        for (int k = 0; k < 32; ++k) { const f32x4 pv = *(const LAS f32x4*)(Pt + (s0 + k) * 4); o0 += pv.x * v[k]; o1 += pv.y * v[k]; o2 += pv.z * v[k]; o3 += pv.w * v[k]; }
    }
#pragma unroll
    for (int k = 0; k < 4; ++k) { const float v = bf2f(Vb[blk_off(MP + 4 * b + k, g * 64 + lane, 256)]); const f32x4 pv = *(const LAS f32x4*)(Pt + (128 + k) * 4); o0 += pv.x * v; o1 += pv.y * v; o2 += pv.z * v; o3 += pv.w * v; }
    { const int orow = MP + 4 * b + t, oc = (4 * g) * 64 + lane;
      O[blk_off(orow, oc, D)] = (bf16)f2bf(o0 * linv[0]); O[blk_off(orow, oc + 64, D)] = (bf16)f2bf(o1 * linv[1]); O[blk_off(orow, oc + 128, D)] = (bf16)f2bf(o2 * linv[2]); O[blk_off(orow, oc + 192, D)] = (bf16)f2bf(o3 * linv[3]); }
    LDS_WAIT(); asm volatile("" ::: "memory");
}
__device__ __forceinline__ void attn_phase(Frame& F) {
    unsigned char* ws = KWS();
    const bf16* Q = (const bf16*)(ws + WS_Q); const bf16* Kb = (const bf16*)(ws + WS_K); const bf16* Vb = (const bf16*)(ws + WS_V); bf16* O = (bf16*)(ws + WS_O);
    for (int task = F.wave * F.G + (int)blockIdx.x; task < DECB * NKV * DECT; task += NWAVES * F.G) attn_sample_task(F, task >> 4, (task >> 2) & 3, task & 3, Q, Kb, Vb, O, KIN(2), KIN(3), KIN(9));
    __syncthreads();
    attn_prompt_units(F, Q, Kb, Vb, O, KIN(9));
}

__device__ __forceinline__ void conv_fixup(Frame& F, int bx) {
    unsigned char* ws = KWS(); const bf16* XBC = (const bf16*)(ws + WS_XBC); bf16* XC = (bf16*)(ws + WS_XC);
    const float* cwp = KIN(12); const float* cbp = KIN(13);
    const int tid = F.wave * 64 + lane_id_opaque(), ri = tid >> 5, chunk = tid & 31;
    pg8::StaticOrder S; S.init(MP, 2048, F.G, bx, WGM_OF(2048, 256));
#define CF_LOAD(u_, xw_, wv_, cbv_) do { const int row_ = (u_).pm * 256 + 64 * (ri / 3) + (ri % 3), t_ = row_ & (SEQ - 1), col_ = ((u_).pn >> 1) * 256 + 8 * chunk; \
        cbv_[0] = *(const f32x4*)(cbp + col_); cbv_[1] = *(const f32x4*)(cbp + col_ + 4); \
        _Pragma("unroll") for (int k = 0; k <= 3; ++k) { xw_[k] = (v4u){0u, 0u, 0u, 0u}; if (t_ - k >= 0) xw_[k] = *(const v4u*)(XBC + (size_t)(row_ - k) * D + col_); \
            wv_[k][0] = *(const f32x4*)(cwp + (3 - k) * D + col_); wv_[k][1] = *(const f32x4*)(cwp + (3 - k) * D + col_ + 4); } } while (0)
#define CF_DO(u_, xw_, wv_, cbv_) do { const int row_ = (u_).pm * 256 + 64 * (ri / 3) + (ri % 3), col_ = ((u_).pn >> 1) * 256 + 8 * chunk; f32x4 x0 = cbv_[0], x1 = cbv_[1]; \
        _Pragma("unroll") for (int k = 0; k <= 3; ++k) { const v4u w = xw_[k];        \
            x0 = x0 + wv_[k][0] * (f32x4){bflo(w.x), bfhi(w.x), bflo(w.y), bfhi(w.y)}; x1 = x1 + wv_[k][1] * (f32x4){bflo(w.z), bfhi(w.z), bflo(w.w), bfhi(w.w)}; } \
        *(v4u*)(XC + blk_off(row_, col_, D)) = pack8(x0, x1); } while (0)
    if (ri < 12) {
        pg8::Unit ua, ub; v4u xA[4], xB[4]; f32x4 wA[4][2], wB[4][2], cA[2], cB[2];
        bool ha = S.next(0, ua);
        if (ha) CF_LOAD(ua, xA, wA, cA);
        for (int i = 0; ha; i += 2) {
            const bool hb = S.next(i + 1, ub);
            if (hb) CF_LOAD(ub, xB, wB, cB);
            CF_DO(ua, xA, wA, cA);
            if (!hb) break;
            ha = S.next(i + 2, ua);
            if (ha) CF_LOAD(ua, xA, wA, cA);
            CF_DO(ub, xB, wB, cB);
        }
    }
#undef CF_LOAD
#undef CF_DO
    VM_WAIT(); __syncthreads();
}

constexpr int SCH = 128, NSCH = SEQ / SCH;
__device__ __forceinline__ void scan1_phase(Frame& F) {
    unsigned char* ws = KWS(); const _Float16* LA = (const _Float16*)(ws + WS_LA); const _Float16* BB = (const _Float16*)(ws + WS_BB);
    float* SLA = (float*)(ws + WS_SLA); float* HT = (float*)(ws + WS_HT); float* SUBS = (float*)(ws + WS_SUBS); float* SUBH = (float*)(ws + WS_SUBH);
    const int tid = F.wave * 64 + lane_id_opaque(), q = tid >> 7, cg = tid & 127, d = 8 * cg;
    LAS float* P = (LAS float*)F.lds;
    for (int u = F.vcu; u < BATCH * NSCH; u += F.G) {
        const int row0 = u * SCH + 32 * q;
        float S[8], H[8];
#pragma unroll
        for (int e = 0; e < 8; ++e) { S[e] = 0.f; H[e] = 0.f; }
#define SC1_LOAD(la_, bb_, i0_) do { _Pragma("unroll") for (int r_ = 0; r_ < 4; ++r_) { const unsigned o_ = blk_off(row0 + (i0_) + r_, d, D); la_[r_] = *(const h16x8*)(LA + o_); bb_[r_] = *(const h16x8*)(BB + o_); } } while (0)
#define SC1_FOLD(la_, bb_) do { _Pragma("unroll") for (int r_ = 0; r_ < 4; ++r_) { _Pragma("unroll") for (int e = 0; e < 8; ++e) { const float l = (float)la_[r_][e]; S[e] += l; const float a = ex2(l); \
            H[e] = a * H[e] + __builtin_amdgcn_sqrtf(fmaf(-a, a, 1.0f)) * (float)bb_[r_][e]; } } } while (0)
        { h16x8 laA[4], bbA[4], laB[4], bbB[4];
          SC1_LOAD(laA, bbA, 0);
#pragma unroll 1
          for (int i = 0; i < 32; i += 8) {
              SC1_LOAD(laB, bbB, i + 4); __builtin_amdgcn_sched_barrier(0);
              SC1_FOLD(laA, bbA); __builtin_amdgcn_sched_barrier(0);
              if (i + 8 < 32) SC1_LOAD(laA, bbA, i + 8);
              __builtin_amdgcn_sched_barrier(0);
              SC1_FOLD(laB, bbB); __builtin_amdgcn_sched_barrier(0); } }
#undef SC1_LOAD
#undef SC1_FOLD
        { float* ps = SUBS + (size_t)(u * 4 + q) * D + d; float* ph = SUBH + (size_t)(u * 4 + q) * D + d;
          *(f32x4*)ps = (f32x4){S[0], S[1], S[2], S[3]}; *(f32x4*)(ps + 4) = (f32x4){S[4], S[5], S[6], S[7]}; *(f32x4*)ph = (f32x4){H[0], H[1], H[2], H[3]}; *(f32x4*)(ph + 4) = (f32x4){H[4], H[5], H[6], H[7]}; }
#pragma unroll
        for (int e = 0; e < 8; ++e) { P[(q * 128 + cg) * 16 + e] = S[e]; P[(q * 128 + cg) * 16 + 8 + e] = H[e]; }
        __syncthreads();
        if (q == 0) { float St[8], Ht[8];
#pragma unroll
            for (int e = 0; e < 8; ++e) { St[e] = 0.f; Ht[e] = 0.f; }
#pragma unroll
            for (int w = 0; w < 4; ++w)
#pragma unroll
                for (int e = 0; e < 8; ++e) { const float s2 = P[(w * 128 + cg) * 16 + e], h2 = P[(w * 128 + cg) * 16 + 8 + e]; St[e] += s2; Ht[e] = Ht[e] * ex2(s2) + h2; }
            float* ps = SLA + (size_t)u * D + d; float* ph = HT + (size_t)u * D + d;
            *(f32x4*)ps = (f32x4){St[0], St[1], St[2], St[3]}; *(f32x4*)(ps + 4) = (f32x4){St[4], St[5], St[6], St[7]}; *(f32x4*)ph = (f32x4){Ht[0], Ht[1], Ht[2], Ht[3]}; *(f32x4*)(ph + 4) = (f32x4){Ht[4], Ht[5], Ht[6], Ht[7]}; }
        __syncthreads();
    }
}
__device__ __forceinline__ void scan2_phase(Frame& F) {
    unsigned char* ws = KWS(); const _Float16* LA = (const _Float16*)(ws + WS_LA); const _Float16* BB = (const _Float16*)(ws + WS_BB);
    const bf16* GG = (const bf16*)(ws + WS_GG); bf16* A2 = (bf16*)(ws + WS_XBC);
    const float* SLA = (const float*)(ws + WS_SLA); const float* HT = (const float*)(ws + WS_HT); const float* SUBS = (const float*)(ws + WS_SUBS); const float* SUBH = (const float*)(ws + WS_SUBH);
    const int tid = F.wave * 64 + lane_id_opaque(), q = tid >> 7, cg = tid & 127, d = 8 * cg;
    LAS float* C = (LAS float*)F.lds;
    for (int u = F.vcu; u < BATCH * NSCH + DECB / 4; u += F.G) {
        float h[8]; int row0, nrow;
        if (u < BATCH * NSCH) {
            const int b = u / NSCH, c = u % NSCH;
            if (q == 0) {
#pragma unroll
                for (int e = 0; e < 8; ++e) h[e] = 0.f;
#pragma unroll 4
                for (int cc = 0; cc < c; ++cc) { const float* ps = SLA + (size_t)(b * NSCH + cc) * D + d; const float* ph = HT + (size_t)(b * NSCH + cc) * D + d;
                    const f32x4 s0 = *(const f32x4*)ps, s1 = *(const f32x4*)(ps + 4), t0 = *(const f32x4*)ph, t1 = *(const f32x4*)(ph + 4);
#pragma unroll
                    for (int e = 0; e < 4; ++e) { h[e] = ex2(s0[e]) * h[e] + t0[e]; h[4 + e] = ex2(s1[e]) * h[4 + e] + t1[e]; } }
#pragma unroll
                for (int e = 0; e < 8; ++e) C[cg * 8 + e] = h[e];
            }
            __syncthreads();
#pragma unroll
            for (int e = 0; e < 8; ++e) h[e] = C[cg * 8 + e];
            for (int qq = 0; qq < q; ++qq) { const float* ps = SUBS + (size_t)(u * 4 + qq) * D + d; const float* ph = SUBH + (size_t)(u * 4 + qq) * D + d;
                const f32x4 s0 = *(const f32x4*)ps, s1 = *(const f32x4*)(ps + 4), t0 = *(const f32x4*)ph, t1 = *(const f32x4*)(ph + 4);
#pragma unroll
                for (int e = 0; e < 4; ++e) { h[e] = ex2(s0[e]) * h[e] + t0[e]; h[4 + e] = ex2(s1[e]) * h[4 + e] + t1[e]; } }
            row0 = u * SCH + 32 * q; nrow = 32;
        } else { const int b = (u - BATCH * NSCH) * 4 + q; const float* hp = KIN(5) + (size_t)b * D + d; const f32x4 a0 = *(const f32x4*)hp, a1 = *(const f32x4*)(hp + 4);
#pragma unroll
            for (int e = 0; e < 4; ++e) { h[e] = a0[e]; h[4 + e] = a1[e]; }
            row0 = MP + 4 * b; nrow = 4; __syncthreads(); }
#define SC2_LOAD(la_, bb_, gw_, i0_) do { _Pragma("unroll") for (int r_ = 0; r_ < 4; ++r_) { const unsigned o_ = blk_off(row0 + (i0_) + r_, d, D); la_[r_] = *(const h16x8*)(LA + o_); bb_[r_] = *(const h16x8*)(BB + o_); gw_[r_] = *(const v4u*)(GG + o_); } } while (0)
#define SC2_SCAN(la_, bb_, gw_, i0_) do { _Pragma("unroll") for (int r_ = 0; r_ < 4; ++r_) { const v4u gw = gw_[r_]; \
            const float gg[8] = {bflo(gw.x), bfhi(gw.x), bflo(gw.y), bfhi(gw.y), bflo(gw.z), bfhi(gw.z), bflo(gw.w), bfhi(gw.w)}; float o[8]; \
            _Pragma("unroll") for (int e = 0; e < 8; ++e) { const float a = ex2((float)la_[r_][e]); h[e] = a * h[e] + __builtin_amdgcn_sqrtf(fmaf(-a, a, 1.0f)) * (float)bb_[r_][e]; o[e] = h[e] * gg[e]; } \
            *(v4u*)(A2 + blk_off(row0 + (i0_) + r_, d, D)) = pack8((f32x4){o[0], o[1], o[2], o[3]}, (f32x4){o[4], o[5], o[6], o[7]}); } } while (0)
        { h16x8 laA[4], bbA[4], laB[4], bbB[4]; v4u gwA[4], gwB[4];
          SC2_LOAD(laA, bbA, gwA, 0);
#pragma unroll 1
          for (int i = 0; i < nrow; i += 8) {
              if (i + 4 < nrow) SC2_LOAD(laB, bbB, gwB, i + 4);
              __builtin_amdgcn_sched_barrier(0);
              SC2_SCAN(laA, bbA, gwA, i); __builtin_amdgcn_sched_barrier(0);
              if (i + 4 < nrow) {
                  if (i + 8 < nrow) SC2_LOAD(laA, bbA, gwA, i + 8);
                  __builtin_amdgcn_sched_barrier(0);
                  SC2_SCAN(laB, bbB, gwB, i + 4); __builtin_amdgcn_sched_barrier(0); } } }
#undef SC2_LOAD
#undef SC2_SCAN
        float* nh = nullptr;
        if (u < BATCH * NSCH) { if ((u % NSCH) == NSCH - 1 && q == 3) nh = KOUT() + OFF_NH_P + (size_t)(u / NSCH) * D + d; }
        else nh = KOUT() + OFF_NH_S + (size_t)((u - BATCH * NSCH) * 4 + q) * D + d;
        if (nh) { *(f32x4*)nh = (f32x4){h[0], h[1], h[2], h[3]}; *(f32x4*)(nh + 4) = (f32x4){h[4], h[5], h[6], h[7]}; }
        __syncthreads();
    }
}
__device__ __forceinline__ void final_norm_phase(Frame& F) {
    unsigned char* ws = KWS(); const float* SS = (const float*)(ws + WS_SS); const bf16* XB = (const bf16*)(ws + WS_XB); const float* g = KIN(23); float* out = KOUT();
    const int lane = lane_id_opaque();
    const int gw = F.vcu * NWAVES + F.wave, NGW = F.G * NWAVES;
    f32x4 gv[2][2];
#pragma unroll
    for (int j = 0; j < 2; ++j) { gv[j][0] = *(const f32x4*)(g + 8 * lane + 512 * j); gv[j][1] = *(const f32x4*)(g + 8 * lane + 512 * j + 4); }
    for (int m0 = 2 * gw; m0 < M; m0 += 2 * NGW) {
        float rs0, rs1;
        if (m0 < MP) { rs0 = rstd_of(*(const f32x4*)(SS + (size_t)m0 * 8), *(const f32x4*)(SS + (size_t)m0 * 8 + 4));
            rs1 = rstd_of(*(const f32x4*)(SS + (size_t)(m0 + 1) * 8), *(const f32x4*)(SS + (size_t)(m0 + 1) * 8 + 4)); }
        else { const float* sp = (const float*)(ws + WS_SSS) + (size_t)(m0 - MP) * 16;
            rs0 = rstd_of(*(const f32x4*)sp + *(const f32x4*)(sp + 4), *(const f32x4*)(sp + 8) + *(const f32x4*)(sp + 12));
            rs1 = rstd_of(*(const f32x4*)(sp + 16) + *(const f32x4*)(sp + 20), *(const f32x4*)(sp + 24) + *(const f32x4*)(sp + 28)); }
        v4u w0[2], w1[2];
#pragma unroll
        for (int j = 0; j < 2; ++j) { const int col = 8 * lane + 512 * j; w0[j] = *(const GAS v4u*)(XB + blk_off(m0, col, D)); w1[j] = *(const GAS v4u*)(XB + blk_off(m0 + 1, col, D)); }
#pragma unroll
        for (int j = 0; j < 2; ++j) { const int col = 8 * lane + 512 * j; float* y0 = out + (size_t)m0 * D + col; float* y1 = y0 + D;
            *(GAS f32x4*)y0 = (f32x4){bflo(w0[j].x), bfhi(w0[j].x), bflo(w0[j].y), bfhi(w0[j].y)} * rs0 * gv[j][0]; *(GAS f32x4*)(y0 + 4) = (f32x4){bflo(w0[j].z), bfhi(w0[j].z), bflo(w0[j].w), bfhi(w0[j].w)} * rs0 * gv[j][1];
            *(GAS f32x4*)y1 = (f32x4){bflo(w1[j].x), bfhi(w1[j].x), bflo(w1[j].y), bfhi(w1[j].y)} * rs1 * gv[j][0]; *(GAS f32x4*)(y1 + 4) = (f32x4){bflo(w1[j].z), bfhi(w1[j].z), bflo(w1[j].w), bfhi(w1[j].w)} * rs1 * gv[j][1]; }
    }
}
__device__ __forceinline__ void shadow_step(Frame& F, const bool early, const int mandw, const bool fin) {
    const int gw = F.vcu * NWAVES + F.wave, NGW = F.G * NWAVES, NW = IT4 - IT1;
    const int ktot = NW > gw ? (NW - gw + NGW - 1) / NGW : 0, kmand = mandw > gw ? (mandw - gw + NGW - 1) / NGW : 0;
    int kend = kmand; if (early) { kend = F.wk + 2 > kmand ? F.wk + 2 : kmand; } if (kend > ktot) kend = ktot;
    const bool spare = early && F.wk >= ktot;
    if (F.wk < kend) { LAS float* scr = (LAS float*)(F.lds + F.wave * 16384); const int lane = lane_id_opaque(); unsigned char* ws = KWS();
        for (; F.wk < kend; ++F.wk) tr_dispatch(ws, scr, IT1 + gw + F.wk * NGW, lane); }
    if (fin) { while (F.cck * NGW < CC_NC) { cache_chunk_step(F); ++F.cck; } }
    else if (spare && F.cck * NGW < CC_NC) { cache_chunk_step(F); ++F.cck; }
}
struct Args { const float* in[24]; float* out; unsigned char* ws; int ph_lo, ph_hi; };
constexpr int N_PHASES = 14;
__global__ void __launch_bounds__(NWAVES * 64, 2) mega_fwd(Args  ) {
    extern __shared__ __attribute__((aligned(16))) unsigned char lds[];
    Frame F;
    F.lds = (LAS unsigned char*)lds; F.MISC = (volatile LAS unsigned*)(F.lds + MISC_OFF);
    { const int tid0 = threadIdx.x; F.wave = __builtin_amdgcn_readfirstlane(tid0 >> 6);
      for (int u = tid0; u < (LDS_BYTES - LDSCTL_OFF) / 4; u += NWAVES * 64) ((LAS unsigned*)(F.lds + LDSCTL_OFF))[u] = 0u; }
    F.G = gridDim.x; { const int bx = blockIdx.x; F.vcu = (F.G % 8 == 0) ? (bx % 8) * (F.G / 8) + bx / 8 : bx; }
    F.cck = 0; F.wk = 0; F.dry = 0;
    __syncthreads();
    const int lo = karg<int>(208), hi = karg<int>(212);
    const bool use_bar = (hi - lo) > 1;
    XcdBarrier bar; bar.bar = (unsigned*)(KWS() + WS_CTL) + CW_BAR; bar.x = 0; bar.st = nullptr; bar.G = 0; bar.wave = F.wave;
    if (use_bar) bar = xcd_barrier_post((unsigned*)(KWS() + WS_CTL) + CW_BAR, F.MISC + 8, F.wave, (unsigned)F.G);
#define IN(k) (lo <= (k) && (k) < hi)
#define SEAM(k) do { if (IN(k) && IN((k) + 1)) { xcd_barrier(bar); if (PROBE_BAR2) xcd_barrier(bar); } } while (0)
#define SEAM_SHADOW(k, lo_, hi_) do { if (IN(k) && IN((k) + 1)) { xcd_arrive(bar); tr_range(F, lo_, 0, tr_count(F, lo_, hi_)); xcd_wait(bar); } else if (IN(k)) { tr_range(F, lo_, 0, tr_count(F, lo_, hi_)); } } while (0)
#define RUNPH_S(k, stmt, lo_, hi_) do { if (IN(k)) { stmt; } SEAM_SHADOW(k, lo_, hi_); } while (0)
#define WSP(T, off) ((T)(KWS() + (off)))
#ifndef PG_ALIGN
#define PG_ALIGN true
#endif
#ifndef PROBE_BAR2
#define PROBE_BAR2 0
#endif
#ifndef PROBE_MASK
#define PROBE_MASK 0
#endif
#ifndef PG_SP2
#define PG_SP2 true
#endif
#ifndef STAGGER
#define STAGGER 1
#endif
#ifndef PROBE_SKINNY
#define PROBE_SKINNY 0
#endif
#ifndef STAG_KEY
#define STAG_KEY(v) ((v) & 3)
#endif

    const int bx = (int)blockIdx.x;
#define GEMM_BIG(OP, Aoff, lda_, ashift, aelems, Boff, ldb_, K_, N_) \
        { pg8::Gemm g{WSP(const bf16*, Aoff), WSP(const bf16*, Boff), K_, lda_, ldb_, ashift, (aelems) * 32};        pg8::StaticOrder S; S.init(MP, N_, F.G, bx, WGM_OF(N_, K_)); Epi8<OP> E{F.lds}; \
          pg8::gemm_phase<Epi8<OP>, pg8::StaticOrder, (OP::HAS_SS || PG_ALIGN), PG_SP2>(F.lds, F.wave, g, S, E); }
#define SK_C64(OP, N_) ((N_) == D && OP::HAS_SS)
#define GEMM_SKINNY(OP, Aoff, lda_, ashift, aelems, Boff, ldb_, K_, N_, kb_, ke_) \
        { if (PROBE_SK_RES && OP::HAS_SS && (PROBE_SK_RES == 1 || (PROBE_SK_RES == 2) == ((K_) > 1024))) { F.dry = 1; skinny_phase<OP, SK_C64(OP, N_)>(F, WSP(const bf16*, Aoff), lda_, ashift, aelems, WSP(const bf16*, Boff), ldb_, K_, (N_) / 256, kb_, ke_); F.dry = 0; } \
          skinny_phase<OP, SK_C64(OP, N_)>(F, WSP(const bf16*, Aoff), lda_, ashift, aelems, WSP(const bf16*, Boff), ldb_, K_, (N_) / 256, kb_, ke_); \
          if (PROBE_SKINNY && !OP::HAS_SS) skinny_phase<OP, SK_C64(OP, N_)>(F, WSP(const bf16*, Aoff), lda_, ashift, aelems, WSP(const bf16*, Boff), ldb_, K_, (N_) / 256, kb_, ke_); }
#define GEMM_PHASE(OP, Aoff, lda_, ashift, aelems, Boff, ldb_, K_, N_) do { \
        const int nsk_ = ((N_) / 256) * (SK_C64(OP, N_) ? 64 : 32), nw_ = F.vcu < nsk_ ? (nsk_ - F.vcu + F.G - 1) / F.G : 0, nf_ = STAGGER ? (nw_ * STAG_KEY(F.vcu) + 1) / 3 : 0; \
        GEMM_SKINNY(OP, Aoff, lda_, ashift, aelems, Boff, ldb_, K_, N_, 0, nf_) __syncthreads(); \
        GEMM_BIG(OP, Aoff, lda_, ashift, aelems, Boff, ldb_, K_, N_) \
        GEMM_SKINNY(OP, Aoff, lda_, ashift, aelems, Boff, ldb_, K_, N_, nf_, nw_) } while (0)
#define RUNPH(k, stmt) do { if (IN(k)) { stmt; if ((PROBE_MASK >> (k)) & 1) { __syncthreads(); stmt; } } SEAM(k); } while (0)
#define MANDW(k) ((k) < 1 ? 0 : (k) < 2 ? I_O : (k) < 3 ? I_O + I_FI : (k) < 4 ? I_O + I_FI + I_FO : (k) < 5 ? I_O + I_FI + I_FO + I_RI : (k) < 8 ? I_O + I_FI + I_FO + I_RI + 8 * I_G : \
                  (k) < 9 ? I_O + I_FI + I_FO + I_RI + 8 * I_G + I_RO : (k) < 10 ? I_O + 2 * I_FI + I_FO + I_RI + 8 * I_G + I_RO : (IT4 - IT1))
#define RUNPH_C(k, stmt, FIN) do { if (IN(k)) { stmt; } if (IN(k) && IN((k) + 1)) { xcd_arrive(bar); __syncthreads(); shadow_step(F, bar.st[3] != 0u, MANDW(k), FIN); xcd_wait(bar); } } while (0)
    RUNPH_C(0, p0_prologue(F), false);
    RUNPH_C(1, GEMM_PHASE(OpQKV, WS_XB, D, 0, 0, WS_WQKV, D, D, NQKV), false);
    RUNPH_C(2, attn_phase(F), false);
    RUNPH_C(3, GEMM_PHASE(OpRes, WS_O, D, 0, 0, WS_WO, D, D, D), false);
    RUNPH_C(4, GEMM_PHASE(OpSwiglu, WS_XB, D, 0, 0, WS_WFI0, D, D, 2 * DFF), false);
    RUNPH_C(5, GEMM_PHASE(OpRes, WS_H, DFF, 0, 0, WS_WFO0, DFF, DFF, D), false);
    RUNPH_C(6, GEMM_PHASE(OpRecIn, WS_XB, D, 0, 0, WS_WRI, D, D, 2048), false);
    RUNPH_C(7, { conv_fixup(F, bx); GEMM_PHASE(OpGates, WS_XC, D, 1, 256, WS_WG, 256, 256, 2048); }, false);
    RUNPH_C(8, scan1_phase(F), false);
    RUNPH_C(9, scan2_phase(F), false);
    RUNPH_C(10, GEMM_PHASE(OpRes, WS_XBC, D, 0, 0, WS_WRO, D, D, D), false);
    RUNPH_C(11, GEMM_PHASE(OpSwiglu, WS_XB, D, 0, 0, WS_WFI1, D, D, 2 * DFF), false);
    RUNPH_C(12, GEMM_PHASE(OpRes, WS_H, DFF, 0, 0, WS_WFO1, DFF, DFF, D), true);
    if (IN(13)) { final_norm_phase(F); if ((PROBE_MASK >> 13) & 1) final_norm_phase(F); }
#undef IN
#undef SEAM
#undef WSP
}

#ifndef MK_ONE_LAUNCH
#define MK_ONE_LAUNCH 1
#endif
extern "C" void kernel_launch(void* const* d_in, const int* in_sizes, int n_in, void* d_out, int out_size, void* d_ws, size_t ws_size, hipStream_t stream) {
    static int grid = 0;
    if (grid == 0) {
        if (n_in != 24 || ws_size < WS_END) { fprintf(stderr, "kernel_launch: unexpected n_in %d / ws %zu\n", n_in, ws_size); grid = -1; return; }
        int dev = 0, cus = 0, per_cu = 0;
        if (hipGetDevice(&dev) != hipSuccess || hipDeviceGetAttribute(&cus, hipDeviceAttributeMultiprocessorCount, dev) != hipSuccess) { grid = -1; return; }
        if (hipFuncSetAttribute((const void*)mega_fwd, hipFuncAttributeMaxDynamicSharedMemorySize, LDS_BYTES) != hipSuccess) { fprintf(stderr, "kernel_launch: hipFuncSetAttribute failed\n"); grid = -1; return; }
        if (hipOccupancyMaxActiveBlocksPerMultiprocessor(&per_cu, (const void*)mega_fwd, NWAVES * 64, LDS_BYTES) != hipSuccess || per_cu < 1) { fprintf(stderr, "kernel_launch: occupancy query says %d\n", per_cu); (void)hipGetLastError(); grid = -1; return; }
        grid = cus;
    }
    if (grid < 0) return;
    (void)hipMemsetAsync((char*)d_ws + WS_CTL, 0, CTL_ZERO_BYTES, stream);
    Args a{};
    for (int i = 0; i < 24; ++i) a.in[i] = (const float*)d_in[i];
    a.out = (float*)d_out; a.ws = (unsigned char*)d_ws;
#if MK_ONE_LAUNCH
    a.ph_lo = 0; a.ph_hi = N_PHASES;
    hipLaunchKernelGGL(mega_fwd, dim3(grid), dim3(NWAVES * 64), LDS_BYTES, stream, a);
#else
    for (int p = 0; p < N_PHASES; ++p) { a.ph_lo = p; a.ph_hi = p + 1; hipLaunchKernelGGL(mega_fwd, dim3(grid), dim3(NWAVES * 64), LDS_BYTES, stream, a); }
#endif
}
```
